# Optimizing an MI355X kernel written in HIP

```python
import jax
import jax.numpy as jnp
from jax import lax
import numpy as np

D_MODEL = 1024
BATCH = 16
SEQ = 2048
DEPTH = 2

GRID_W = 64
CTX_LEN = 256

CONV_DIM = 512
CONV_WIDTH = 31
NA_HEADS = 8
NA_HEAD_DIM = 64
NA_DIM = NA_HEADS * NA_HEAD_DIM
NA_KH_MAX = 8
NA_KW = 16
C_HEADS = 16
C_KV_HEADS = 4
C_GROUP = C_HEADS // C_KV_HEADS
C_HEAD_DIM = 64
C_WINDOW = 128
C_BLOCK = 128
ROPE_BASE = 10000.0
N_GROUPS = 4
EXPERTS_PER_GROUP = 4
N_EXPERTS = N_GROUPS * EXPERTS_PER_GROUP
TOP_K = 2
D_EXPERT = 256

LN_EPS = 1e-5
NEG_INF = -1e30

kernel_name = 'hybrid_conv_natten_swa_hmoe_dit'


def layer_norm(x, g, b):
    xf = x.astype(jnp.float32)
    mu = jnp.mean(xf, axis=-1, keepdims=True)
    var = jnp.mean(jnp.square(xf - mu), axis=-1, keepdims=True)
    return ((xf - mu) * lax.rsqrt(var + LN_EPS)).astype(x.dtype) * g + b


def axial_rope_tables(n_tokens, head_dim):
    t = jnp.arange(n_tokens)
    row = (t // GRID_W).astype(jnp.float32)
    col = (t % GRID_W).astype(jnp.float32)
    axis_dim = head_dim // 2
    inv_freq = ROPE_BASE ** (-jnp.arange(0, axis_dim, 2, dtype=jnp.float32) / axis_dim)
    ang = jnp.concatenate([row[:, None] * inv_freq, col[:, None] * inv_freq], axis=-1)
    return jnp.cos(ang), jnp.sin(ang)


def apply_axial_rope(x, cos, sin):
    xr = x.astype(jnp.float32).reshape(x.shape[:-1] + (2, 2, -1))
    bshape = (1, x.shape[1]) + (1,) * (x.ndim - 3) + (2, cos.shape[-1] // 2)
    cs = cos.reshape(bshape)
    sn = sin.reshape(bshape)
    x1 = xr[..., 0, :]
    x2 = xr[..., 1, :]
    out = jnp.stack([x1 * cs - x2 * sn, x2 * cs + x1 * sn], axis=-2)
    return out.reshape(x.shape).astype(x.dtype)


def depthwise_conv(h, w, b):
    half = w.shape[0] // 2
    out = lax.conv_general_dilated(h, w[:, None, :], window_strides=(1,), padding=[(half, half)],
                                   dimension_numbers=('NWC', 'WIO', 'NWC'),
                                   feature_group_count=h.shape[-1])
    return out + b


def conformer_conv(a, conv_w, conv_b, g, b):
    h = a[..., :CONV_DIM] * jax.nn.sigmoid(a[..., CONV_DIM:])
    h = layer_norm(depthwise_conv(h, conv_w, conv_b), g, b)
    return jax.nn.silu(h)


def context_attention(q, k, v, sink=None):
    s = jnp.einsum('bqhgd,bkhd->bhgqk', q, k).astype(jnp.float32) * (q.shape[-1] ** -0.5)
    if sink is not None:
        sink_col = jnp.broadcast_to(sink.astype(jnp.float32)[None, :, :, None, None], s.shape[:-1] + (1,))
        s = jnp.concatenate([s, sink_col], axis=-1)
    p = jax.nn.softmax(s, axis=-1)[..., :k.shape[1]].astype(v.dtype)
    return jnp.einsum('bhgqk,bkhd->bqhgd', p, v)


def neighbourhood_attention(q, k, v, k_ctx, v_ctx, rpb, rows):
    bsz = q.shape[0]
    kh = min(NA_KH_MAX, rows)
    n_win = kh * GRID_W
    grid = lambda t: t.reshape(bsz, rows, GRID_W, NA_HEADS, NA_HEAD_DIM)
    qg, kg, vg = grid(q), grid(k), grid(v)
    r = np.arange(rows)
    row_start = np.clip(r - kh // 2, 0, rows - kh)
    row_off = row_start[:, None] + np.arange(kh)[None, :] - r[:, None] + NA_KH_MAX - 1
    j = np.arange(GRID_W)
    col_start = np.clip(j - NA_KW // 2, 0, GRID_W - NA_KW)
    col_in = (j[None, :] >= col_start[:, None]) & (j[None, :] < col_start[:, None] + NA_KW)
    col_off = np.clip(j[None, :] - j[:, None], -(NA_KW - 1), NA_KW - 1) + NA_KW - 1
    bias = rpb.astype(jnp.float32)[:, row_off][:, :, :, col_off]
    bias = jnp.where(col_in[None, None, None], bias, NEG_INF)
    bias = bias.transpose(1, 0, 3, 2, 4).reshape(rows, NA_HEADS, GRID_W, n_win)
    scale = NA_HEAD_DIM ** -0.5

    def row_step(args):
        start, q_row, b_row = args
        k_blk = lax.dynamic_slice_in_dim(kg, start, kh, axis=1).reshape(bsz, n_win, NA_HEADS, NA_HEAD_DIM)
        v_blk = lax.dynamic_slice_in_dim(vg, start, kh, axis=1).reshape(bsz, n_win, NA_HEADS, NA_HEAD_DIM)
        s_lat = jnp.einsum('bqhd,bkhd->bhqk', q_row, k_blk).astype(jnp.float32) * scale + b_row
        s_ctx = jnp.einsum('bqhd,bkhd->bhqk', q_row, k_ctx).astype(jnp.float32) * scale
        p = jax.nn.softmax(jnp.concatenate([s_lat, s_ctx], axis=-1), axis=-1).astype(v.dtype)
        return (jnp.einsum('bhqk,bkhd->bqhd', p[..., :n_win], v_blk)
                + jnp.einsum('bhqk,bkhd->bqhd', p[..., n_win:], v_ctx))

    out = lax.map(row_step, (jnp.asarray(row_start, jnp.int32), jnp.moveaxis(qg, 1, 0), bias))
    return jnp.moveaxis(out, 0, 1).reshape(bsz, rows * GRID_W, NA_HEADS, NA_HEAD_DIM)


def conv_na_mixer(u_ctx, u_lat, w_in, b_in, conv_w, conv_b, cln_g, cln_b, rpb, w_out, b_out, rows, need_ctx):
    bsz, n_lat, _ = u_lat.shape
    q0 = 2 * CONV_DIM
    kv0 = q0 + NA_DIM
    heads = lambda t: t.reshape(t.shape[:-1] + (NA_HEADS, NA_HEAD_DIM))
    a_lat, q_lat, k_lat, v_lat = jnp.split(u_lat @ w_in + b_in, [q0, kv0, kv0 + NA_DIM], axis=-1)
    k_ctx, v_ctx = jnp.split(u_ctx @ w_in[:, kv0:] + b_in[kv0:], 2, axis=-1)
    k_ctx, v_ctx = heads(k_ctx), heads(v_ctx)
    conv_lat = conformer_conv(a_lat, conv_w, conv_b, cln_g, cln_b)
    na_lat = neighbourhood_attention(heads(q_lat), heads(k_lat), heads(v_lat), k_ctx, v_ctx, rpb, rows)
    o_lat = jnp.concatenate([conv_lat, na_lat.reshape(bsz, n_lat, NA_DIM)], axis=-1) @ w_out + b_out
    o_ctx = None
    if need_ctx:
        a_ctx, q_ctx = jnp.split(u_ctx @ w_in[:, :kv0] + b_in[:kv0], [q0], axis=-1)
        conv_ctx = conformer_conv(a_ctx, conv_w, conv_b, cln_g, cln_b)
        na_ctx = context_attention(heads(q_ctx)[:, :, :, None, :], k_ctx, v_ctx)
        o_ctx = jnp.concatenate([conv_ctx, na_ctx.reshape(bsz, -1, NA_DIM)], axis=-1) @ w_out + b_out
    return o_ctx, o_lat


def banded_window_attention(q, k, v, k_ctx, v_ctx, sink):
    bsz, n, hkv, g, d = q.shape
    nb = n // C_BLOCK
    span = C_BLOCK + 2 * C_WINDOW
    pad = [(0, 0), (C_WINDOW, C_WINDOW), (0, 0), (0, 0)]
    kp = jnp.pad(k, pad)
    vp = jnp.pad(v, pad)
    q_blocks = jnp.moveaxis(q.reshape(bsz, nb, C_BLOCK, hkv, g, d), 1, 0)
    scale = d ** -0.5
    sink_col = jnp.broadcast_to(sink.astype(jnp.float32)[None, :, :, None, None], (bsz, hkv, g, C_BLOCK, 1))

    def block_step(args):
        b_idx, q_blk = args
        start = b_idx * C_BLOCK
        k_blk = lax.dynamic_slice_in_dim(kp, start, span, axis=1)
        v_blk = lax.dynamic_slice_in_dim(vp, start, span, axis=1)
        k_pos = start - C_WINDOW + jnp.arange(span)
        q_pos = start + jnp.arange(C_BLOCK)
        valid = (k_pos >= 0)[None, :] & (k_pos < n)[None, :] & (jnp.abs(q_pos[:, None] - k_pos[None, :]) <= C_WINDOW)
        s_lat = jnp.einsum('bqhgd,bkhd->bhgqk', q_blk, k_blk).astype(jnp.float32) * scale
        s_lat = jnp.where(valid, s_lat, NEG_INF)
        s_ctx = jnp.einsum('bqhgd,bkhd->bhgqk', q_blk, k_ctx).astype(jnp.float32) * scale
        p = jax.nn.softmax(jnp.concatenate([s_lat, s_ctx, sink_col], axis=-1), axis=-1).astype(v.dtype)
        return (jnp.einsum('bhgqk,bkhd->bqhgd', p[..., :span], v_blk)
                + jnp.einsum('bhgqk,bkhd->bqhgd', p[..., span:span + k_ctx.shape[1]], v_ctx))

    out = lax.map(block_step, (jnp.arange(nb, dtype=jnp.int32), q_blocks))
    return jnp.moveaxis(out, 0, 1).reshape(bsz, n, hkv, g, d)


def window_gqa_mixer(u_ctx, u_lat, w_in, sink, w_out, rope_cos, rope_sin, need_ctx):
    bsz, n_lat, _ = u_lat.shape
    q_cols = C_HEADS * C_HEAD_DIM
    kv_cols = C_KV_HEADS * C_HEAD_DIM
    qh = lambda t: t.reshape(t.shape[:-1] + (C_KV_HEADS, C_GROUP, C_HEAD_DIM))
    kvh = lambda t: t.reshape(t.shape[:-1] + (C_KV_HEADS, C_HEAD_DIM))
    q_lat, k_lat, v_lat = jnp.split(u_lat @ w_in, [q_cols, q_cols + kv_cols], axis=-1)
    k_ctx, v_ctx = jnp.split(u_ctx @ w_in[:, q_cols:], [kv_cols], axis=-1)
    k_ctx, v_ctx = kvh(k_ctx), kvh(v_ctx)
    q_lat = apply_axial_rope(qh(q_lat), rope_cos, rope_sin)
    k_lat = apply_axial_rope(kvh(k_lat), rope_cos, rope_sin)
    sink_hg = sink.reshape(C_KV_HEADS, C_GROUP)
    o_lat = banded_window_attention(q_lat, k_lat, kvh(v_lat), k_ctx, v_ctx, sink_hg)
    o_lat = o_lat.reshape(bsz, n_lat, q_cols) @ w_out
    o_ctx = None
    if need_ctx:
        q_ctx = qh(u_ctx @ w_in[:, :q_cols])
        o_ctx = context_attention(q_ctx, k_ctx, v_ctx, sink_hg).reshape(bsz, -1, q_cols) @ w_out
    return o_ctx, o_lat


def hier_moe(u, router_g, router_e, w_gate, w_up, w_down):
    t = u.shape[0]
    g_prob = jax.nn.softmax((u @ router_g).astype(jnp.float32), axis=-1)
    g_p, g_idx = lax.top_k(g_prob, 1)
    e_logits = (u @ router_e).astype(jnp.float32).reshape(t, N_GROUPS, EXPERTS_PER_GROUP)
    e_logits = jnp.take_along_axis(e_logits, g_idx[:, :, None], axis=1)[:, 0]
    e_top, e_idx = lax.top_k(e_logits, TOP_K)
    e_w = jax.nn.softmax(e_top, axis=-1) * g_p
    within = jnp.einsum('tk,tke->te', e_w, jax.nn.one_hot(e_idx, EXPERTS_PER_GROUP, dtype=jnp.float32))
    gates = (jax.nn.one_hot(g_idx[:, 0], N_GROUPS, dtype=jnp.float32)[:, :, None] * within[:, None, :]).astype(u.dtype)
    wg = w_gate.reshape(N_GROUPS, EXPERTS_PER_GROUP, D_MODEL, D_EXPERT)
    wu = w_up.reshape(N_GROUPS, EXPERTS_PER_GROUP, D_MODEL, D_EXPERT)
    wd = w_down.reshape(N_GROUPS, EXPERTS_PER_GROUP, D_EXPERT, D_MODEL)
    y = jnp.zeros_like(u)
    for g in range(N_GROUPS):
        h = jax.nn.silu(jnp.einsum('td,edf->tef', u, wg[g])) * jnp.einsum('td,edf->tef', u, wu[g])
        y = y + jnp.einsum('tef,efd->td', h * gates[:, g, :, None], wd[g])
    return y


def setup_inputs(seed: int = 0) -> dict:
    key = jax.random.key(seed)
    ks = iter(jax.random.split(key, 32))
    f32 = jnp.float32
    n_even = (DEPTH + 1) // 2
    n_odd = DEPTH // 2
    beta = (8.0 * DEPTH) ** -0.25
    ab_cols = 2 * CONV_DIM + 3 * NA_DIM
    gqa_cols = (C_HEADS + 2 * C_KV_HEADS) * C_HEAD_DIM

    def nrm(shape, scale):
        return jax.random.normal(next(ks), shape, f32) * scale

    return {
        'x': nrm((BATCH, SEQ, D_MODEL), 1.0),
        'c': nrm((BATCH, D_MODEL), 1.0),
        'ctx': nrm((BATCH, CTX_LEN, D_MODEL), 1.0),
        'c_ctx': nrm((D_MODEL,), 1.0),
        'ada_w': nrm((DEPTH, D_MODEL, 6 * D_MODEL), 0.5 * D_MODEL ** -0.5),
        'ada_b': nrm((DEPTH, 6 * D_MODEL), 0.02),
        'ln_g': 1.0 + nrm((DEPTH, 2, D_MODEL), 0.02),
        'ln_b': nrm((DEPTH, 2, D_MODEL), 0.02),
        'ab_w_in': nrm((n_even, D_MODEL, ab_cols), D_MODEL ** -0.5),
        'ab_b_in': nrm((n_even, ab_cols), 0.02),
        'conv_w': nrm((n_even, CONV_WIDTH, CONV_DIM), CONV_WIDTH ** -0.5),
        'conv_b': nrm((n_even, CONV_DIM), 0.02),
        'conv_ln_g': 1.0 + nrm((n_even, CONV_DIM), 0.02),
        'conv_ln_b': nrm((n_even, CONV_DIM), 0.02),
        'na_rpb': nrm((n_even, NA_HEADS, 2 * NA_KH_MAX - 1, 2 * NA_KW - 1), 0.1),
        'ab_w_out': nrm((n_even, CONV_DIM + NA_DIM, D_MODEL), beta * (CONV_DIM + NA_DIM) ** -0.5),
        'ab_b_out': nrm((n_even, D_MODEL), 0.02),
        'gqa_w_in': nrm((n_odd, D_MODEL, gqa_cols), D_MODEL ** -0.5),
        'gqa_sink': nrm((n_odd, C_HEADS), 0.5),
        'gqa_w_out': nrm((n_odd, C_HEADS * C_HEAD_DIM, D_MODEL), beta * (C_HEADS * C_HEAD_DIM) ** -0.5),
        'router_group': nrm((DEPTH, D_MODEL, N_GROUPS), D_MODEL ** -0.5),
        'router_expert': nrm((DEPTH, D_MODEL, N_EXPERTS), D_MODEL ** -0.5),
        'exp_w_gate': nrm((DEPTH, N_EXPERTS, D_MODEL, D_EXPERT), D_MODEL ** -0.5),
        'exp_w_up': nrm((DEPTH, N_EXPERTS, D_MODEL, D_EXPERT), D_MODEL ** -0.5),
        'exp_w_down': nrm((DEPTH, N_EXPERTS, D_EXPERT, D_MODEL), beta * D_EXPERT ** -0.5),
    }


def reference(x, c, ctx, c_ctx, ada_w, ada_b, ln_g, ln_b, ab_w_in, ab_b_in, conv_w, conv_b, conv_ln_g,
              conv_ln_b, na_rpb, ab_w_out, ab_b_out, gqa_w_in, gqa_sink, gqa_w_out, router_group,
              router_expert, exp_w_gate, exp_w_up, exp_w_down):
    alpha = (2.0 * DEPTH) ** 0.25
    bsz, n_lat, _ = x.shape
    n_ctx = ctx.shape[1]
    rows = n_lat // GRID_W
    rope_cos, rope_sin = axial_rope_tables(n_lat, C_HEAD_DIM)
    silu_c = jax.nn.silu(c)
    silu_cc = jax.nn.silu(c_ctx)
    h_lat, h_ctx = x, ctx
    for i in range(DEPTH):
        j = i // 2
        need_ctx = i < DEPTH - 1
        m_lat = jnp.split((silu_c @ ada_w[i] + ada_b[i])[:, None, :], 6, axis=-1)
        m_ctx = jnp.split(silu_cc @ ada_w[i] + ada_b[i], 6, axis=-1)
        u_lat = h_lat * (1.0 + m_lat[1]) + m_lat[0]
        u_ctx = h_ctx * (1.0 + m_ctx[1]) + m_ctx[0]
        if i % 2 == 0:
            o_ctx, o_lat = conv_na_mixer(u_ctx, u_lat, ab_w_in[j], ab_b_in[j], conv_w[j], conv_b[j],
                                         conv_ln_g[j], conv_ln_b[j], na_rpb[j], ab_w_out[j], ab_b_out[j],
                                         rows, need_ctx)
        else:
            o_ctx, o_lat = window_gqa_mixer(u_ctx, u_lat, gqa_w_in[j], gqa_sink[j], gqa_w_out[j],
                                            rope_cos, rope_sin, need_ctx)
        h_lat = layer_norm(alpha * h_lat + m_lat[2] * o_lat, ln_g[i, 0], ln_b[i, 0])
        t_lat = h_lat * (1.0 + m_lat[4]) + m_lat[3]
        if need_ctx:
            h_ctx = layer_norm(alpha * h_ctx + m_ctx[2] * o_ctx, ln_g[i, 0], ln_b[i, 0])
            t_ctx = h_ctx * (1.0 + m_ctx[4]) + m_ctx[3]
            tokens = jnp.concatenate([t_ctx, t_lat], axis=1)
        else:
            tokens = t_lat
        y = hier_moe(tokens.reshape(-1, D_MODEL), router_group[i], router_expert[i], exp_w_gate[i],
                     exp_w_up[i], exp_w_down[i]).reshape(bsz, -1, D_MODEL)
        h_lat = layer_norm(alpha * h_lat + m_lat[5] * y[:, y.shape[1] - n_lat:], ln_g[i, 1], ln_b[i, 1])
        if need_ctx:
            h_ctx = layer_norm(alpha * h_ctx + m_ctx[5] * y[:, :n_ctx], ln_g[i, 1], ln_b[i, 1])
    return h_lat
```

```cpp
#include <hip/hip_runtime.h>
#include <cstdint>
#include <cstdio>

typedef unsigned short bf16;
__device__ __forceinline__ float bf2f(bf16 v) { return __uint_as_float(((unsigned)v) << 16); }
__device__ __forceinline__ bf16 f2bf(float f) { unsigned u = __float_as_uint(f); return (bf16)((u + 0x7fffu + ((u >> 16) & 1u)) >> 16); }

constexpr int D = 1024, NB = 16, SEQ = 2048, CL = 256;
constexpr int NL = NB * SEQ, NC = NB * CL, NT = NL + NC;
constexpr float ALPHA = 1.41421356237309515f;
constexpr float LN_EPS = 1e-5f;
constexpr float NEG_INF = -1e30f;

constexpr size_t MiB = 1u << 20;
constexpr size_t WS_CTL = 0, WS_MOD = 1 * MiB, WS_ROPE = 2 * MiB, WS_TOKE = 3 * MiB, WS_TOKW = 3 * MiB + 512 * 1024;
constexpr size_t WS_HC = 72 * MiB, WS_ACT = 88 * MiB, WS_PROJ = 160 * MiB, WS_CAT = 340 * MiB, WS_END = 494 * MiB;

__device__ __forceinline__ int mod_row(int r) { return r < NL ? (r >> 11) : 16; }
__device__ __forceinline__ float silu_f(float x) { return x / (1.f + __expf(-x)); }


namespace pg8 {
#define PG8_LAS __attribute__((address_space(3)))
typedef unsigned short bf16_t;
typedef short bf16x8 __attribute__((ext_vector_type(8)));
typedef float f32x4 __attribute__((ext_vector_type(4)));
typedef unsigned u32x4 __attribute__((ext_vector_type(4)));
constexpr int BM = 256, BK = 64, HALF = 128, HTB = HALF * BK * 2  , STAGE_BYTES = 8 * HTB, NXCD = 8, WGM = 8;

__host__ __device__ __forceinline__ int lds_byte(int r, int c) { const int st = (r >> 4) * 2 + (c >> 5), rr = r & 15, cc = c & 31, ob = rr * 64 + cc * 2; return st * 1024 + (ob ^ (((ob >> 9) & 1) << 5)); }
__host__ __device__ __forceinline__ void stage_rc(int b, int& R, int& C) { const int st = b / 1024, sb = b % 1024, swz = sb ^ (((sb >> 9) & 1) << 5); R = (st >> 1) * 16 + swz / 64; C = (st & 1) * 32 + (swz % 64) / 2; }
__host__ __device__ __forceinline__ int perm32(int rho) { const int n = rho >> 4, i = rho & 15; return 8 * (i >> 2) + 4 * n + (i & 3); }

struct Unit { int pm, pn; };
struct Gemm { const bf16_t* A; const bf16_t* Bt; int M, N, K; };

struct StaticOrder {
    int nM, nN, nwg, G, c;
    __host__ __device__ void init(int M, int N, int G_, int c_) { nM = M / BM; nN = N / BM; nwg = nM * nN; G = G_; c = c_; }
    __host__ __device__ bool next(int i, Unit& u) const {
        const long L = (long)i * G + c; if (L >= nwg) return false;
        int wgid = (int)L; { const int q = nwg / NXCD, r = nwg % NXCD, xcd = wgid % NXCD, off = wgid / NXCD; wgid = (xcd < r ? xcd * (q + 1) : r * (q + 1) + (xcd - r) * q) + off; }
        const int nig = WGM * nN, gid = wgid / nig, fm = gid * WGM, gsz = (nM - fm) < WGM ? (nM - fm) : WGM;
        u.pm = fm + ((wgid % nig) % gsz); u.pn = (wgid % nig) / gsz; return true;
    }
    __device__ __forceinline__ void a_ready(const Unit&) const {}
    __device__ __forceinline__ void done(const Unit&) const {}
};

__device__ __forceinline__ unsigned cvt_pk_bf16(float lo, float hi) { unsigned r; asm volatile("v_cvt_pk_bf16_f32 %0, %1, %2" : "=v"(r) : "v"(lo), "v"(hi)); return r; }
typedef unsigned u32x2 __attribute__((ext_vector_type(2)));
constexpr int EP_NL = 32768;
struct EpiBias {
    static constexpr bool PERM = true, AFTER_DRAIN = false;
    bf16_t* O; int ldc; const float* bias; int sc_lo, sc_hi; float sc; int nostore;
    __device__ __forceinline__ void operator()(const f32x4 (&acc)[2][2][4][2], const Unit& u, int wr, int wc, int fr, int fq) const {
        const int row0 = u.pm * BM + wr * 64 + fr; const int col0 = u.pn * BM + wc * 32 + 8 * fq;
        f32x4 bv[2][2];
#pragma unroll
        for (int bj = 0; bj < 2; ++bj)
#pragma unroll
            for (int n = 0; n < 2; ++n) bv[bj][n] = bias ? *(const f32x4*)(bias + col0 + bj * HALF + 4 * n) : (f32x4){0.f, 0.f, 0.f, 0.f};
#pragma unroll
        for (int ai = 0; ai < 2; ++ai)
#pragma unroll
            for (int m = 0; m < 4; ++m) { bf16_t* rowp = O + (size_t)(row0 + ai * HALF + m * 16) * ldc + col0;
#pragma unroll
                for (int bj = 0; bj < 2; ++bj) { const int cg = col0 + bj * HALF; const float sf = (cg >= sc_lo && cg < sc_hi) ? sc : 1.0f;
                    const f32x4 v0 = (acc[ai][bj][m][0] + bv[bj][0]) * sf, v1 = (acc[ai][bj][m][1] + bv[bj][1]) * sf;
                    u32x4 w; w.x = cvt_pk_bf16(v0[0], v0[1]); w.y = cvt_pk_bf16(v0[2], v0[3]); w.z = cvt_pk_bf16(v1[0], v1[1]); w.w = cvt_pk_bf16(v1[2], v1[3]);
                    if (!nostore) *(u32x4*)(rowp + bj * HALF) = w; else asm volatile("" :: "v"(w)); } }
    }
};
struct EpiIn0 {
    static constexpr bool PERM = true, AFTER_DRAIN = false;
    bf16_t* O; const float* bias; float qs; int nostore;
    __device__ __forceinline__ void operator()(const f32x4 (&acc)[2][2][4][2], const Unit& u, int wr, int wc, int fr, int fq) const {
        const int row0 = u.pm * BM + wr * 64 + fr; const int col0 = u.pn * BM + wc * 32 + 8 * fq;
        f32x4 bv[2][2];
#pragma unroll
        for (int bj = 0; bj < 2; ++bj)
#pragma unroll
            for (int n = 0; n < 2; ++n) bv[bj][n] = *(const f32x4*)(bias + col0 + bj * HALF + 4 * n);
#pragma unroll
        for (int ai = 0; ai < 2; ++ai)
#pragma unroll
            for (int m = 0; m < 4; ++m) { bf16_t* rowp = O + (size_t)(row0 + ai * HALF + m * 16) * 2560;
#pragma unroll
                for (int bj = 0; bj < 2; ++bj) { const int cg = col0 + bj * HALF;
                    f32x4 v0 = acc[ai][bj][m][0] + bv[bj][0], v1 = acc[ai][bj][m][1] + bv[bj][1];
                    if (cg < 1024) {
                        f32x4 h;
#pragma unroll
                        for (int q = 0; q < 4; ++q) h[q] = v0[q] * __builtin_amdgcn_rcpf(1.0f + __expf(-v1[q]));
                        u32x2 w; w.x = cvt_pk_bf16(h[0], h[1]); w.y = cvt_pk_bf16(h[2], h[3]);
                        if (!nostore) *(u32x2*)(rowp + (cg >> 1)) = w; else asm volatile("" :: "v"(w));
                    } else {
                        const float sf = cg < 1536 ? qs : 1.0f; v0 = v0 * sf; v1 = v1 * sf;
                        u32x4 w; w.x = cvt_pk_bf16(v0[0], v0[1]); w.y = cvt_pk_bf16(v0[2], v0[3]); w.z = cvt_pk_bf16(v1[0], v1[1]); w.w = cvt_pk_bf16(v1[2], v1[3]);
                        if (!nostore) *(u32x4*)(rowp + cg) = w; else asm volatile("" :: "v"(w));
                    } } }
    }
};
struct EpiRope {
    static constexpr bool PERM = true, AFTER_DRAIN = false;
    bf16_t* O; const PG8_LAS float* rt;
    __device__ __forceinline__ void operator()(const f32x4 (&acc)[2][2][4][2], const Unit& u, int wr, int wc, int fr, int fq) const {
        const int row0 = u.pm * BM + wr * 64 + fr; const int c8b = u.pn * BM + wc * 32 + 8 * fq;
        const bool lat = (u.pm * BM) < EP_NL;
#pragma unroll
        for (int ai = 0; ai < 2; ++ai)
#pragma unroll
            for (int m = 0; m < 4; ++m) { const int row = row0 + ai * HALF + m * 16; const int t = row & 2047; bf16_t* rowp = O + (size_t)row * 1536;
#pragma unroll
                for (int bj = 0; bj < 2; ++bj) { const int c8 = c8b + bj * HALF; const f32x4 v0 = acc[ai][bj][m][0], v1 = acc[ai][bj][m][1];
                    if (c8 < 1280) {
                        const int head = c8 >> 6, pos = c8 & 63, a = pos >> 5, i0 = ((pos & 31) >> 3) * 4;
                        f32x4 o1 = v0, o2 = v1;
                        if (lat) { const int e = (a == 0 ? (t >> 6) : 32 + (t & 63)) * 16 + i0;
                            const f32x4 cs = *(const PG8_LAS f32x4*)(rt + e), sn = *(const PG8_LAS f32x4*)(rt + 1536 + e);
                            o1 = v0 * cs - v1 * sn; o2 = v1 * cs + v0 * sn; }
                        if (c8 < 1024) { o1 = o1 * 0.18033688011112042f; o2 = o2 * 0.18033688011112042f; }
                        u32x2 w1, w2; w1.x = cvt_pk_bf16(o1[0], o1[1]); w1.y = cvt_pk_bf16(o1[2], o1[3]); w2.x = cvt_pk_bf16(o2[0], o2[1]); w2.y = cvt_pk_bf16(o2[2], o2[3]);
                        bf16_t* p = rowp + head * 64 + a * 32 + i0;
                        *(u32x2*)p = w1; *(u32x2*)(p + 16) = w2;
                    } else {
                        u32x4 w; w.x = cvt_pk_bf16(v0[0], v0[1]); w.y = cvt_pk_bf16(v0[2], v0[3]); w.z = cvt_pk_bf16(v1[0], v1[1]); w.w = cvt_pk_bf16(v1[2], v1[3]);
                        *(u32x4*)(rowp + c8) = w;
                    } } }
    }
};
struct OrderL1 {
    StaticOrder so; int G, c;
    __device__ void init(int G_, int c_) { so.init(EP_NL, 1536, G_, c_); G = G_; c = c_; }
    __device__ bool next(int i, Unit& u) const {
        const long L = (long)i * G + c;
        if (L < so.nwg) return so.next(i, u);
        const int idx = (int)(L - so.nwg); if (idx >= 32) return false;
        u.pm = 128 + (idx >> 1); u.pn = 4 + (idx & 1); return true;
    }
    __device__ __forceinline__ void a_ready(const Unit&) const {}
    __device__ __forceinline__ void done(const Unit&) const {}
};
constexpr int MOE_CAP = 73728;
__device__ __forceinline__ int xcd_remap(int wgid, int nwg) { const int q = nwg / NXCD, r = nwg % NXCD, xcd = wgid % NXCD, off = wgid / NXCD; return (xcd < r ? xcd * (q + 1) : r * (q + 1) + (xcd - r) * q) + off; }
template <int NPN> struct OrderMoE {
    const PG8_LAS int* ts; const int* list; int G, c, nwg;
    __device__ void init(const PG8_LAS int* ts_, const int* list_, int G_, int c_) { ts = ts_; list = list_; G = G_; c = c_; nwg = __builtin_amdgcn_readfirstlane(ts_[16]) * NPN; }
    __device__ __forceinline__ unsigned a_rowoff(const Unit& u, int row) const { const int e = u.pn / NPN, p = (u.pm - __builtin_amdgcn_readfirstlane(ts[e])) * 256 + row;
        const int slot = p < __builtin_amdgcn_readfirstlane(ts[32 + e]) ? list[(size_t)e * MOE_CAP + p] : 0; return (unsigned)(slot >> 1) * 2048u; }
    __device__ bool next(int i, Unit& u) const {
        const long L = (long)i * G + c; if (L >= nwg) return false;
        const int wgid = xcd_remap((int)L, nwg), rt = wgid / NPN, pc = wgid % NPN;
        int e = 0;
#pragma unroll
        for (int j = 1; j < 16; ++j) e += (rt >= __builtin_amdgcn_readfirstlane(ts[j])) ? 1 : 0;
        u.pm = rt; u.pn = e * NPN + pc; return true;
    }
    __device__ __forceinline__ void a_ready(const Unit&) const {}
    __device__ __forceinline__ void done(const Unit&) const {}
};
struct EpiGLU {
    static constexpr bool PERM = true, AFTER_DRAIN = false;
    bf16_t* H; const float* listw; const PG8_LAS int* ts;
    __device__ __forceinline__ void operator()(const f32x4 (&acc)[2][2][4][2], const Unit& u, int wr, int wc, int fr, int fq) const {
        const int row0 = u.pm * BM + wr * 64 + fr; const int hc0 = (u.pn & 1) * 128 + wc * 16 + 4 * fq;
        const int e = u.pn >> 1, p0 = (u.pm - ts[e]) * 256 + wr * 64 + fr, cnt = ts[32 + e]; const float* lw = listw + (size_t)e * MOE_CAP;
#pragma unroll
        for (int ai = 0; ai < 2; ++ai)
#pragma unroll
            for (int m = 0; m < 4; ++m) { const int row = row0 + ai * HALF + m * 16; const int p = p0 + ai * HALF + m * 16; const float w = p < cnt ? lw[p] : 0.f; bf16_t* rowp = H + (size_t)row * 256 + hc0;
#pragma unroll
                for (int bj = 0; bj < 2; ++bj) { const f32x4 g = acc[ai][bj][m][0], uu = acc[ai][bj][m][1]; f32x4 h;
#pragma unroll
                    for (int q = 0; q < 4; ++q) h[q] = g[q] * __builtin_amdgcn_rcpf(1.0f + __expf(-g[q])) * uu[q] * w;
                    u32x2 o; o.x = cvt_pk_bf16(h[0], h[1]); o.y = cvt_pk_bf16(h[2], h[3]);
                    *(u32x2*)(rowp + bj * 64) = o; } }
    }
};
struct EpiScatter {
    static constexpr bool PERM = true, AFTER_DRAIN = false;
    bf16_t* YP; const int* list; const PG8_LAS int* ts; int ntok; int nostore;
    __device__ __forceinline__ void operator()(const f32x4 (&acc)[2][2][4][2], const Unit& u, int wr, int wc, int fr, int fq) const {
        const unsigned col0 = (unsigned)((u.pn & 3) * BM + wc * 32 + 8 * fq);
        const int e = u.pn >> 2, p0 = (u.pm - ts[e]) * 256 + wr * 64 + fr, cnt = ts[32 + e]; const int* ls = list + (size_t)e * MOE_CAP;
#pragma unroll
        for (int ai = 0; ai < 2; ++ai)
#pragma unroll
            for (int m = 0; m < 4; ++m) { const int p = p0 + ai * HALF + m * 16; const int s = p < cnt ? ls[p] : -1;
                if (s >= 0) { const unsigned off = ((unsigned)(s & 1) * (unsigned)ntok + (unsigned)(s >> 1)) * 1024u + col0;
#pragma unroll
                    for (int bj = 0; bj < 2; ++bj) { const f32x4 v0 = acc[ai][bj][m][0], v1 = acc[ai][bj][m][1];
                        u32x4 w; w.x = cvt_pk_bf16(v0[0], v0[1]); w.y = cvt_pk_bf16(v0[2], v0[3]); w.z = cvt_pk_bf16(v1[0], v1[1]); w.w = cvt_pk_bf16(v1[2], v1[3]);
                        if (!nostore) *(u32x4*)(YP + off + bj * HALF) = w; else asm volatile("" :: "v"(w)); } }
                asm volatile("" ::: "memory"); }
    }
};
template <class Epi, class Sched, bool ALIGN_EPI = false, bool SP2 = false, bool GATHER = false>
__device__ __forceinline__ void gemm_phase(PG8_LAS unsigned char* lds, const Gemm g, const Sched& S, const Epi& E) {
    const int tid = threadIdx.x, wid = __builtin_amdgcn_readfirstlane(tid >> 6), lane = tid & 63, wr = wid >> 2, wc = wid & 3, fr = lane & 15, fq = lane >> 4;
    const int K = g.K, nt = K / BK;
    unsigned voffA[2], voffB[2];
#pragma unroll
    for (int i = 0; i < 2; ++i) { int R, C; stage_rc(tid * 16 + i * 8192, R, C); const int Rb = Epi::PERM ? ((R & ~31) + perm32(R & 31)) : R;
        voffA[i] = (unsigned)(R * K + C) * 2u; voffB[i] = (unsigned)(Rb * K + C) * 2u; }
    const size_t kstep = (size_t)(BK * 2);
    const size_t hstep = (size_t)HALF * K * 2;
    const size_t tstep = 2 * hstep;
    const unsigned ldsw = (unsigned)wid * 1024u;
    const int aoff = lds_byte(wr * 64 + fr, fq * 8), boff = lds_byte(wc * 32 + fr, fq * 8);
#define PG8_SA(b, h) (((b) * 2 + (h)) * HTB)
#define PG8_SB(b, h) ((4 + (b) * 2 + (h)) * HTB)
#define PG8_STAGE_A(bufoff, gbase, h, nx) do { if constexpr (GATHER) { _Pragma("unroll") for (int _i = 0; _i < 2; ++_i) \
        __builtin_amdgcn_global_load_lds((const unsigned*)((const char*)(gbase) + ((nx) ? gn[h][_i] : gc[h][_i])), (PG8_LAS unsigned*)(lds + (bufoff) + ldsw + _i * 8192), 16, 0, 0); } \
        else { PG8_STAGE(bufoff, (gbase) + (h) * hstep, voffA); } } while (0)
#define PG8_STAGE(bufoff, gbase, voff) do { _Pragma("unroll") for (int _i = 0; _i < 2; ++_i) \
        __builtin_amdgcn_global_load_lds((const unsigned*)((const char*)(gbase) + (voff)[_i]), (PG8_LAS unsigned*)(lds + (bufoff) + ldsw + _i * 8192), 16, 0, 0); } while (0)
#define PG8_LDA(dst, b, h) do { _Pragma("unroll") for (int m = 0; m < 4; ++m) _Pragma("unroll") for (int k = 0; k < 2; ++k) dst[m][k] = *(const PG8_LAS bf16x8*)(lds + PG8_SA(b, h) + aoff + m * 2048 + k * 1024); } while (0)
#define PG8_LDB(dst, b, h) do { _Pragma("unroll") for (int n = 0; n < 2; ++n) _Pragma("unroll") for (int k = 0; k < 2; ++k) dst[n][k] = *(const PG8_LAS bf16x8*)(lds + PG8_SB(b, h) + boff + n * 2048 + k * 1024); } while (0)
#define PG8_MMA(ai, bj, At, Bt) do { __builtin_amdgcn_s_setprio(1); _Pragma("unroll") for (int m = 0; m < 4; ++m) _Pragma("unroll") for (int n = 0; n < 2; ++n) _Pragma("unroll") for (int k = 0; k < 2; ++k) \
        acc[ai][bj][m][n] = __builtin_amdgcn_mfma_f32_16x16x32_bf16(Bt[n][k], At[m][k], acc[ai][bj][m][n], 0, 0, 0); __builtin_amdgcn_s_setprio(0); } while (0)
#define PG8_WAIT_V(n) asm volatile("s_waitcnt vmcnt(" #n ")" ::: "memory")
#define PG8_WAIT_L(n) asm volatile("s_waitcnt lgkmcnt(" #n ")" ::: "memory")
#define PG8_BAR __builtin_amdgcn_s_barrier()
#define PG8_SCHED __builtin_amdgcn_sched_barrier(0)
    Unit cur, nxt; int ui = 0;
    if (!S.next(0, cur)) return;
    f32x4 acc[2][2][4][2];
#pragma unroll
    for (int a = 0; a < 2; ++a)
#pragma unroll
        for (int b = 0; b < 2; ++b)
#pragma unroll
            for (int m = 0; m < 4; ++m)
#pragma unroll
                for (int n = 0; n < 2; ++n) acc[a][b][m][n] = (f32x4){0.f, 0.f, 0.f, 0.f};
    bf16x8 At[4][2], B0[2][2], B1[2][2];
    const char* cA = (const char*)g.A + (GATHER ? (size_t)0 : (size_t)cur.pm * tstep); const char* cB = (const char*)g.Bt + (size_t)cur.pn * tstep;
    unsigned gc[2][2], gn[2][2];
    if constexpr (GATHER) {
#pragma unroll
        for (int h = 0; h < 2; ++h)
#pragma unroll
            for (int i = 0; i < 2; ++i) { int R, C; stage_rc(tid * 16 + i * 8192, R, C); gc[h][i] = S.a_rowoff(cur, h * HALF + R) + (unsigned)C * 2u; gn[h][i] = gc[h][i]; } }
    S.a_ready(cur);
    if constexpr (SP2) {
        PG8_STAGE(PG8_SB(0, 0), cB, voffB); PG8_STAGE(PG8_SB(0, 1), cB + hstep, voffB); PG8_STAGE_A(PG8_SA(0, 0), cA, 0, false); PG8_STAGE_A(PG8_SA(0, 1), cA, 1, false);
        if (wr == 1) PG8_BAR;
        PG8_WAIT_V(2); PG8_BAR;
        PG8_STAGE(PG8_SB(1, 0), cB + kstep, voffB); PG8_STAGE_A(PG8_SA(1, 0), cA + kstep, 0, false); PG8_STAGE(PG8_SB(1, 1), cB + hstep + kstep, voffB);
        PG8_WAIT_V(6); PG8_BAR;
    } else {
        PG8_STAGE(PG8_SB(0, 0), cB, voffB); PG8_STAGE_A(PG8_SA(0, 0), cA, 0, false); PG8_STAGE(PG8_SB(0, 1), cB + hstep, voffB); PG8_STAGE_A(PG8_SA(0, 1), cA, 1, false);
        if (wr == 1) PG8_BAR;
        PG8_WAIT_V(4); PG8_BAR;
        PG8_STAGE(PG8_SB(1, 0), cB + kstep, voffB); PG8_STAGE_A(PG8_SA(1, 0), cA + kstep, 0, false); PG8_STAGE(PG8_SB(1, 1), cB + hstep + kstep, voffB);
        PG8_WAIT_V(6); PG8_BAR;
    }
    for (;;) {
        const bool has_next = S.next(ui + 1, nxt);
        if constexpr (GATHER) { if (has_next) {
#pragma unroll
            for (int h = 0; h < 2; ++h)
#pragma unroll
                for (int i = 0; i < 2; ++i) { int R, C; stage_rc(tid * 16 + i * 8192, R, C); gn[h][i] = S.a_rowoff(nxt, h * HALF + R) + (unsigned)C * 2u; } } }
        const char* nA = GATHER ? (const char*)g.A : (has_next ? (const char*)g.A + (size_t)nxt.pm * tstep : cA); const char* nB = has_next ? (const char*)g.Bt + (size_t)nxt.pn * tstep : cB;
        for (int t = 0; t < nt; t += 2) {
            const bool last = (t == nt - 2);
            const char* a1 = cA + (size_t)(t + 1) * kstep;
            const char* a2 = last ? nA : cA + (size_t)(t + 2) * kstep; const char* b2 = last ? nB : cB + (size_t)(t + 2) * kstep;
            const char* a3 = a2 + kstep; const char* b3 = b2 + kstep;
            if (last && has_next) S.a_ready(nxt);
            if constexpr (SP2) {
            PG8_LDB(B0, 0, 0); PG8_LDB(B1, 0, 1); PG8_SCHED; PG8_LDA(At, 0, 0); PG8_STAGE_A(PG8_SA(1, 1), a1, 1, false);
            PG8_WAIT_V(8); PG8_WAIT_L(0); PG8_BAR; PG8_MMA(0, 0, At, B0); PG8_MMA(0, 1, At, B1); PG8_BAR; PG8_SCHED;
            PG8_LDA(At, 0, 1); PG8_STAGE(PG8_SB(0, 0), b2, voffB); PG8_STAGE(PG8_SB(0, 1), b2 + hstep, voffB); PG8_STAGE_A(PG8_SA(0, 0), a2, 0, last);
            PG8_WAIT_V(8); PG8_WAIT_L(0); PG8_BAR; PG8_MMA(1, 0, At, B0); PG8_MMA(1, 1, At, B1); PG8_BAR; PG8_SCHED;
            PG8_LDB(B0, 1, 0); PG8_LDB(B1, 1, 1); PG8_SCHED; PG8_LDA(At, 1, 0); PG8_STAGE_A(PG8_SA(0, 1), a2, 1, last);
            PG8_WAIT_V(8); PG8_WAIT_L(0); PG8_BAR; PG8_MMA(0, 0, At, B0); PG8_MMA(0, 1, At, B1); PG8_BAR; PG8_SCHED;
            PG8_LDA(At, 1, 1); PG8_STAGE(PG8_SB(1, 0), b3, voffB); PG8_STAGE(PG8_SB(1, 1), b3 + hstep, voffB); PG8_STAGE_A(PG8_SA(1, 0), a3, 0, last);
            PG8_WAIT_V(8); PG8_WAIT_L(0); PG8_BAR; PG8_MMA(1, 0, At, B0); PG8_MMA(1, 1, At, B1); PG8_BAR; PG8_SCHED;
            } else {
            PG8_LDB(B0, 0, 0); PG8_SCHED; PG8_LDA(At, 0, 0); PG8_STAGE_A(PG8_SA(1, 1), a1, 1, false);
            PG8_WAIT_L(8); PG8_BAR; PG8_WAIT_L(0); PG8_MMA(0, 0, At, B0); PG8_BAR; PG8_SCHED;
            PG8_LDB(B1, 0, 1); PG8_STAGE(PG8_SB(0, 0), b2, voffB);
            PG8_BAR; PG8_WAIT_L(0); PG8_MMA(0, 1, At, B1); PG8_BAR;
            PG8_LDA(At, 0, 1); PG8_STAGE_A(PG8_SA(0, 0), a2, 0, last);
            PG8_BAR; PG8_WAIT_L(0); PG8_MMA(1, 0, At, B0); PG8_BAR; PG8_SCHED;
            PG8_STAGE(PG8_SB(0, 1), b2 + hstep, voffB);
            PG8_WAIT_V(6); PG8_BAR; PG8_MMA(1, 1, At, B1); PG8_BAR;
            PG8_LDB(B0, 1, 0); PG8_SCHED; PG8_LDA(At, 1, 0); PG8_STAGE_A(PG8_SA(0, 1), a2, 1, last);
            PG8_WAIT_L(8); PG8_BAR; PG8_WAIT_L(0); PG8_MMA(0, 0, At, B0); PG8_BAR; PG8_SCHED;
            PG8_LDB(B1, 1, 1); PG8_STAGE(PG8_SB(1, 0), b3, voffB);
            PG8_BAR; PG8_WAIT_L(0); PG8_MMA(0, 1, At, B1); PG8_BAR;
            PG8_LDA(At, 1, 1); PG8_STAGE_A(PG8_SA(1, 0), a3, 0, last);
            PG8_BAR; PG8_WAIT_L(0); PG8_MMA(1, 0, At, B0); PG8_BAR; PG8_SCHED;
            PG8_STAGE(PG8_SB(1, 1), b3 + hstep, voffB);
            PG8_WAIT_V(6); PG8_BAR; PG8_MMA(1, 1, At, B1); PG8_BAR;
            }
        }
        if constexpr (ALIGN_EPI) { if (wr == 0) PG8_BAR; }
        if constexpr (!Epi::AFTER_DRAIN) { E(acc, cur, wr, wc, fr, fq); S.done(cur); }
        if (!has_next) break;
#pragma unroll
        for (int a = 0; a < 2; ++a)
#pragma unroll
            for (int b = 0; b < 2; ++b)
#pragma unroll
                for (int m = 0; m < 4; ++m)
#pragma unroll
                    for (int n = 0; n < 2; ++n) acc[a][b][m][n] = (f32x4){0.f, 0.f, 0.f, 0.f};
        cur = nxt; cA = nA; cB = nB; ++ui;
        if constexpr (GATHER) {
#pragma unroll
            for (int h = 0; h < 2; ++h)
#pragma unroll
                for (int i = 0; i < 2; ++i) gc[h][i] = gn[h][i]; }
        if constexpr (ALIGN_EPI) { if (wr == 1) PG8_BAR; }
    }
    PG8_WAIT_V(0);
    if constexpr (!ALIGN_EPI) { if (wr == 0) PG8_BAR; }
    PG8_BAR;
    if constexpr (Epi::AFTER_DRAIN) { E.fused(acc, cur, wr, wc, fr, fq, lds, wid, lane); S.done(cur); }
#undef PG8_SA
#undef PG8_SB
#undef PG8_STAGE
#undef PG8_STAGE_A
#undef PG8_LDA
#undef PG8_LDB
#undef PG8_MMA
#undef PG8_WAIT_V
#undef PG8_WAIT_L
#undef PG8_BAR
#undef PG8_SCHED
}
}

constexpr int NWAVES = 8, NTHR = 512;
constexpr int RING_BYTES = 131072;
constexpr int LDSCTL_OFF = 161792, MISC_OFF = LDSCTL_OFF + 320;
constexpr int LDS_BYTES = 163840;
constexpr size_t WS_WIN0 = 8 * MiB, WS_WOUT0 = 13 * MiB, WS_WIN1 = 15 * MiB, WS_WOUT1 = 18 * MiB, WS_WGU = 20 * MiB  , WS_WD = 52 * MiB  ;
constexpr size_t WS_ROPEC = 2 * MiB, WS_ROPES = 2 * MiB + 256 * 1024, WS_BIN0P = 2 * MiB + 512 * 1024;
constexpr size_t CTL_ZERO_BYTES = 1 * MiB;
constexpr int CW_BAR = 4096;

#define GAS __attribute__((address_space(1)))
#define LAS __attribute__((address_space(3)))
typedef unsigned v4u __attribute__((ext_vector_type(4)));
typedef unsigned v2u __attribute__((ext_vector_type(2)));
typedef float f32x4 __attribute__((ext_vector_type(4)));
typedef GAS unsigned gu32;
#define RLX_AGENT __ATOMIC_RELAXED, __HIP_MEMORY_SCOPE_AGENT
#define LDS_WAIT() asm volatile("s_waitcnt lgkmcnt(0)" ::: "memory")
__device__ __forceinline__ unsigned pk2(float lo, float hi) { typedef float f2_t __attribute__((ext_vector_type(2))); typedef __bf16 b2_t __attribute__((ext_vector_type(2)));
    f2_t v = {lo, hi}; b2_t b = __builtin_convertvector(v, b2_t); return __builtin_bit_cast(unsigned, b); }
__device__ __forceinline__ f32x4 unpk4(v2u b) { f32x4 o; o[0] = __uint_as_float(b.x << 16); o[1] = __uint_as_float(b.x & 0xffff0000u); o[2] = __uint_as_float(b.y << 16); o[3] = __uint_as_float(b.y & 0xffff0000u); return o; }
constexpr size_t WS_LIST = 484 * MiB, WS_LISTW = 489 * MiB;
constexpr size_t WS_HB = 412 * MiB;

#define XB_TMO      128
#define XB_XCNT(j)  (256  + 64 * (j))
#define XB_XSUB(j)  (1280 + 64 * (j))
#define XB_XGEN(j)  (2304 + 64 * (j))
#define XB_TOP      3328
#define XB_TOPGEN   3392
#define XCD_BAR_WORDS 3456
#define XB_SPIN_CAP (1u << 18)

__device__ __forceinline__ unsigned xb_ld(unsigned* p)              { return __hip_atomic_load(p, __ATOMIC_RELAXED, __HIP_MEMORY_SCOPE_AGENT); }
__device__ __forceinline__ unsigned xb_add(unsigned* p, unsigned v) { return __hip_atomic_fetch_add(p, v, __ATOMIC_RELAXED, __HIP_MEMORY_SCOPE_AGENT); }
__device__ __forceinline__ unsigned xb_xcc_id() { return (unsigned)__builtin_amdgcn_s_getreg((3 << 11) | 20) & 0xFu; }
#define XB_SPIN(cond, bar) do { unsigned _sp = 0; while (cond) { __builtin_amdgcn_s_sleep(1); \
    if ((++_sp & 255u) == 0u) { if (xb_ld(&(bar)[XB_TMO])) break; if (_sp > XB_SPIN_CAP) { atomicAdd(&(bar)[XB_TMO], 1u); break; } } } } while (0)

struct XcdBarrier {
    unsigned* bar; unsigned x;
    volatile LAS unsigned* st;
};

__device__ __forceinline__ XcdBarrier xcd_barrier_post(unsigned* bar, volatile LAS unsigned* st) {
    XcdBarrier b; b.bar = bar; b.x = xb_xcc_id(); b.st = st;
    if (threadIdx.x == 0) (void)xb_add(&bar[XB_XCNT(b.x)], 1u);
    return b;
}
__device__ __forceinline__ void xcd_barrier_complete(unsigned* bar, unsigned x, unsigned& nloc, unsigned& nx) {
    const unsigned G = gridDim.x * gridDim.y * gridDim.z;
    unsigned sum, cnt, mine, sp = 0u;
    for (;;) {
        sum = 0u; cnt = 0u; mine = 0u;
#pragma unroll
        for (unsigned j = 0; j < 16; ++j) { const unsigned c = xb_ld(&bar[XB_XCNT(j)]); sum += c; cnt += (c > 0u) ? 1u : 0u; mine = (j == x) ? c : mine; }
        if (sum == G) break;
        __builtin_amdgcn_s_sleep(1);
        if ((++sp & 255u) == 0u) { if (xb_ld(&bar[XB_TMO])) break; if (sp > XB_SPIN_CAP) { atomicAdd(&bar[XB_TMO], 1u); break; } }
    }
    nloc = mine > 0u ? mine : 1u; nx = cnt > 0u ? cnt : 1u;
}

__device__ __forceinline__ void xcd_barrier(const XcdBarrier& b) {
    asm volatile("s_waitcnt vmcnt(0)" ::: "memory");
    __syncthreads();
    if (threadIdx.x == 0) {
        unsigned* bar = b.bar;
        __builtin_amdgcn_s_waitcnt(0);
        unsigned nloc = b.st[0], nx = b.st[1];
        if (nloc == 0u) { xcd_barrier_complete(bar, b.x, nloc, nx); b.st[0] = nloc; b.st[1] = nx; }
        const unsigned old = xb_add(&bar[XB_XSUB(b.x)], 1u);
        const unsigned gen = old / nloc;
        if (old + 1u == (gen + 1u) * nloc) {
            __builtin_amdgcn_fence(__ATOMIC_RELEASE, "agent");
            asm volatile("s_waitcnt vmcnt(0)" ::: "memory");
            const unsigned og = xb_add(&bar[XB_TOP], 1u);
            const unsigned tgt = (gen + 1u) * nx;
            if (og + 1u < tgt) XB_SPIN(xb_ld(&bar[XB_TOP]) < tgt, bar);
            __builtin_amdgcn_fence(__ATOMIC_ACQUIRE, "agent");
            asm volatile("s_waitcnt vmcnt(0)" ::: "memory");
        } else {
            XB_SPIN(xb_ld(&bar[XB_TOP]) < (gen + 1u) * nx, bar);
            __builtin_amdgcn_fence(__ATOMIC_ACQUIRE, "agent");
            asm volatile("s_waitcnt vmcnt(0)" ::: "memory");
        }
    }
    __syncthreads();
}


struct Frame {
    LAS unsigned char* lds;
    volatile LAS unsigned* MISC;
    gu32* ctl;
    int tid, lane, wave, vcu, G;
};
struct Args { const float* in[25]; float* out; unsigned char* ws; int ph_lo, ph_hi, li, pad; };

template <int CTRL, int ROW_MASK> __device__ __forceinline__ float dpp_add(float v) {
    return v + __int_as_float(__builtin_amdgcn_update_dpp(0, __float_as_int(v), CTRL, ROW_MASK, 0xf, false));
}
__device__ __forceinline__ float wave_sum(float v) {
    v = dpp_add<0xB1, 0xf>(v);
    v = dpp_add<0x4E, 0xf>(v);
    v = dpp_add<0x141, 0xf>(v);
    v = dpp_add<0x140, 0xf>(v);
    v = dpp_add<0x142, 0xa>(v);
    v = dpp_add<0x143, 0xc>(v);
    return __int_as_float(__builtin_amdgcn_readlane(__float_as_int(v), 63));
}

__device__ __forceinline__ void phase_mods(Frame& F, const float* c, const float* c_ctx, const float* ada_w, const float* ada_b, float* MOD, float* ropeC, float* ropeS) {
    LAS float* S = (LAS float*)F.lds;
    LAS float* PART = (LAS float*)(F.lds + 17 * 1024 * 4);
    {
        f32x4 xv[9];
#pragma unroll
        for (int it = 0; it < 9; ++it) { const int i4 = F.tid + NTHR * it, b = i4 >> 8, k4 = i4 & 255;
            xv[it] = (f32x4){0.f, 0.f, 0.f, 0.f};
            if (i4 < 17 * 256) xv[it] = *(const f32x4*)(b < 16 ? c + b * 1024 + 4 * k4 : c_ctx + 4 * k4); }
#pragma unroll
        for (int it = 0; it < 9; ++it) { const int i4 = F.tid + NTHR * it;
            if (i4 < 17 * 256) { f32x4 y;
#pragma unroll
                for (int e = 0; e < 4; ++e) y[e] = xv[it][e] / (1.f + __expf(-xv[it][e]));
                *(LAS f32x4*)(S + 4 * i4) = y; } }
    }
    __syncthreads();
    for (int cb = F.vcu; cb < 256; cb += F.G) {
        const int l = cb >> 7, col0 = (cb & 127) * 48;
        {
            const int kq = F.lane & 3, c4 = F.lane >> 2;
            f32x4 acc[17];
#pragma unroll
            for (int b = 0; b < 17; ++b) acc[b] = (f32x4){0.f, 0.f, 0.f, 0.f};
            if (c4 < 12) {
                const float* wp = ada_w + ((size_t)l * 1024 + F.wave * 128 + kq) * 6144 + col0 + 4 * c4;
                f32x4 wv[4], wn[4];
#pragma unroll
                for (int q = 0; q < 4; ++q) wv[q] = *(const f32x4*)(wp + (size_t)(4 * q) * 6144);
#pragma unroll 1
                for (int k0 = 0; k0 < 128; k0 += 16) {
                    if (k0 + 16 < 128) {
#pragma unroll
                        for (int q = 0; q < 4; ++q) wn[q] = *(const f32x4*)(wp + (size_t)(k0 + 16 + 4 * q) * 6144); }
#pragma unroll
                    for (int q = 0; q < 4; ++q) { const int k = F.wave * 128 + k0 + 4 * q + kq;
                        float sv[17];
#pragma unroll
                        for (int b = 0; b < 17; ++b) sv[b] = S[b * 1024 + k];
                        __builtin_amdgcn_sched_barrier(0);
#pragma unroll
                        for (int b = 0; b < 17; ++b) acc[b] += wv[q] * sv[b]; }
#pragma unroll
                    for (int q = 0; q < 4; ++q) wv[q] = wn[q]; }
            }
#pragma unroll
            for (int b = 0; b < 17; ++b)
#pragma unroll
                for (int e = 0; e < 4; ++e) acc[b][e] = dpp_add<0x4E, 0xf>(dpp_add<0xB1, 0xf>(acc[b][e]));
            if (kq == 0 && c4 < 12) {
#pragma unroll
                for (int b = 0; b < 17; ++b) *(LAS f32x4*)(PART + (F.wave * 17 + b) * 48 + 4 * c4) = acc[b]; }
        }
        __syncthreads();
        for (int idx = F.tid; idx < 17 * 48; idx += NTHR) { const int b = idx / 48, j = idx % 48; float s = 0.f;
#pragma unroll
            for (int w = 0; w < 8; ++w) s += PART[(w * 17 + b) * 48 + j];
            MOD[((size_t)l * 17 + b) * 6144 + col0 + j] = s + ada_b[l * 6144 + col0 + j]; }
        __syncthreads();
    }
    for (int idx = F.vcu * NTHR + F.tid; idx < 2048 * 32; idx += F.G * NTHR) {
        const int t = idx >> 5, e = idx & 31, a = e >> 4, i = e & 15;
        const float pos = (float)(a == 0 ? (t >> 6) : (t & 63));
        const float ang = pos * powf(10000.f, -(float)i / 16.f);
        ropeC[idx] = cosf(ang); ropeS[idx] = sinf(ang);
    }
}

__device__ __forceinline__ int rowmap(int mode, int n) {
    if (mode == 1) return 8 * (n >> 2) + (n & 3);
    if (mode == 2) return 8 * (n >> 2) + 4 + (n & 3);
    if (mode == 4) { if (n >= 1024) return n; const int c = n & 511; return 8 * (c >> 2) + (n >= 512 ? 4 : 0) + (c & 3); }
    if (mode == 3) { if (n >= 1280) return n; const int head = n >> 6, d = n & 63, a = d >> 5, p = (d >> 4) & 1, i = d & 15; return head * 64 + a * 32 + (i >> 2) * 8 + p * 4 + (i & 3); }
    return n;
}
__device__ __forceinline__ void transpose_item(const float* W, int N, bf16* WT, int K, int mode, LAS float* scr, int item, int lane) {
    const int nblk = N / 32, kb = item / nblk, nb = item % nblk, k0 = 64 * kb, n0 = 32 * nb;
    {
        const int kr = lane >> 3, c4 = 4 * (lane & 7);
        const float* src = W + (size_t)(k0 + kr) * N + n0 + c4;
        f32x4 v[8];
#pragma unroll
        for (int i = 0; i < 8; ++i) v[i] = *(const f32x4*)(src + (size_t)(8 * i) * N);
#pragma unroll
        for (int i = 0; i < 8; ++i) { LAS float* d = scr + (8 * i + kr) * 33 + c4; d[0] = v[i][0]; d[1] = v[i][1]; d[2] = v[i][2]; d[3] = v[i][3]; }
    }
    LDS_WAIT(); asm volatile("" ::: "memory");
    const int c = lane & 7;
#pragma unroll
    for (int j = 0; j < 4; ++j) { const int n = (lane >> 3) + 8 * j; const LAS float* s = scr + (8 * c) * 33 + n;
        v4u o; o.x = pk2(s[0 * 33], s[1 * 33]); o.y = pk2(s[2 * 33], s[3 * 33]); o.z = pk2(s[4 * 33], s[5 * 33]); o.w = pk2(s[6 * 33], s[7 * 33]);
        *(GAS v4u*)(WT + (size_t)rowmap(mode, n0 + n) * K + k0 + 8 * c) = o; }
    LDS_WAIT(); asm volatile("" ::: "memory");
}
__device__ __forceinline__ void prep_items(Frame& F, const Args& A, int lo, int hi, int rank, int nworkers) {
    unsigned char* ws = A.ws;
    LAS float* scr = (LAS float*)(F.lds + F.wave * 16384);
    constexpr int NI_A = 1280, NI_B = NI_A + 512, NI_C = NI_B + 768, NI_D = NI_C + 512;
    for (int it = lo + rank * NWAVES + F.wave; it < hi; it += nworkers * NWAVES) {
        if (it < NI_A) { transpose_item(A.in[8], 2560, (bf16*)(ws + WS_WIN0), 1024, 4, scr, it, F.lane); continue; }
        if (it < NI_B) { transpose_item(A.in[15], 1024, (bf16*)(ws + WS_WOUT0), 1024, 0, scr, it - NI_A, F.lane); continue; }
        if (it < NI_C) { transpose_item(A.in[17], 1536, (bf16*)(ws + WS_WIN1), 1024, 3, scr, it - NI_B, F.lane); continue; }
        if (it < NI_D) { transpose_item(A.in[19], 1024, (bf16*)(ws + WS_WOUT1), 1024, 0, scr, it - NI_C, F.lane); continue; }
        const int r = it - NI_D, le = r / 384, which = (r % 384) >> 7, sub = r & 127;
        if (which == 0) transpose_item(A.in[22] + (size_t)le * 1024 * 256, 256, (bf16*)(ws + WS_WGU) + (size_t)le * 512 * 1024, 1024, 1, scr, sub, F.lane);
        else if (which == 1) transpose_item(A.in[23] + (size_t)le * 1024 * 256, 256, (bf16*)(ws + WS_WGU) + (size_t)le * 512 * 1024, 1024, 2, scr, sub, F.lane);
        else transpose_item(A.in[24] + (size_t)le * 256 * 1024, 1024, (bf16*)(ws + WS_WD) + (size_t)le * 1024 * 256, 256, 0, scr, sub, F.lane);
    }
}
__device__ __forceinline__ void tail_items(Frame& F, const Args& A, int nwg, int lo, int hi) {
    const int rem = nwg % F.G, rank = rem ? (int)blockIdx.x - rem : (int)blockIdx.x, nworkers = rem ? F.G - rem : F.G;
    if (rank >= 0) prep_items(F, A, lo, hi, rank, nworkers);
}
constexpr int PI_L0W = 1792, PI_EXP0 = 3072, PI_EXP1 = 9216, PI_ALL = 15360;
__device__ __forceinline__ void phase_prep(Frame& F, const Args& A) {
    unsigned char* ws = A.ws;
    prep_items(F, A, 0, PI_L0W, F.vcu, F.G);
    for (int n = F.vcu * NTHR + F.tid; n < 2560; n += F.G * NTHR) ((float*)(ws + WS_BIN0P))[rowmap(4, n)] = A.in[9][n];
    const float* MOD = (const float*)(ws + WS_MOD); bf16* ACT = (bf16*)(ws + WS_ACT);
    {
        const int RPB = (NT + F.G - 1) / F.G, r0 = F.vcu * RPB, nloc = min(RPB, max(0, NT - r0));
        f32x4 xN[4], sc[4], sh[4]; int cur_mr = -1;
        if (F.wave < nloc) { const int r = r0 + F.wave; const float* src = r < NL ? A.in[0] + (size_t)r * 1024 : A.in[2] + (size_t)(r - NL) * 1024;
#pragma unroll
            for (int j = 0; j < 4; ++j) xN[j] = *(const f32x4*)(src + 4 * F.lane + 256 * j); }
        for (int rl = F.wave; rl < nloc; rl += NWAVES) { const int r = r0 + rl; const int mr = mod_row(r);
            if (mr != cur_mr) { cur_mr = mr; const float* m = MOD + (size_t)mr * 6144;
#pragma unroll
                for (int j = 0; j < 4; ++j) { const int cc = 4 * F.lane + 256 * j; sc[j] = *(const f32x4*)(m + 1024 + cc) + 1.0f; sh[j] = *(const f32x4*)(m + cc); } }
            f32x4 u[4];
#pragma unroll
            for (int j = 0; j < 4; ++j) u[j] = xN[j] * sc[j] + sh[j];
            if (rl + NWAVES < nloc) { const int rn = r + NWAVES; const float* src = rn < NL ? A.in[0] + (size_t)rn * 1024 : A.in[2] + (size_t)(rn - NL) * 1024;
#pragma unroll
                for (int j = 0; j < 4; ++j) xN[j] = *(const f32x4*)(src + 4 * F.lane + 256 * j); }
#pragma unroll
            for (int j = 0; j < 4; ++j) { v2u o; o.x = pk2(u[j][0], u[j][1]); o.y = pk2(u[j][2], u[j][3]); *(v2u*)(ACT + (size_t)r * 1024 + 4 * F.lane + 256 * j) = o; } }
    }
}

constexpr size_t WS_TOKPOS = WS_TOKE;
constexpr size_t WS_SROWTOK = 4 * MiB, WS_SROWW = 4 * MiB + 512 * 1024;
constexpr int CW_UPC = 40000;
constexpr int CW_CNT = 200000;
constexpr int MOE_LDS = LDSCTL_OFF + 1024;
constexpr int RPBMAX = 512;

template <int L_> __device__ __forceinline__ void moe_tiles(Frame& F) {
    LAS int* TS = (LAS int*)(F.lds + MOE_LDS);
    if (F.tid == 0) { int acc = 0;
        for (int e = 0; e < 16; ++e) { const int c = (int)__hip_atomic_load(F.ctl + CW_CNT + L_ * 64 + e, RLX_AGENT); TS[e] = acc; TS[32 + e] = c; acc += (c + 255) >> 8; }
        TS[16] = acc; }
    __syncthreads();
}

template <int L_> __device__ __forceinline__ void phase_ln1(Frame& F, const Args& A, bool dry) {
    const float* hin_lat = A.in[0]; const float* hin_ctx = A.in[2]; bf16* HB = (bf16*)(A.ws + WS_HB);
    constexpr int nrows = L_ == 0 ? NT : NL;
    unsigned char* ws = A.ws;
    const float* MOD = (const float*)(ws + WS_MOD); const bf16* O = (const bf16*)(ws + WS_PROJ); bf16* ACT = (bf16*)(ws + WS_ACT);
    const float* lng = A.in[6] + (L_ * 2 + 0) * 1024; const float* lnb = A.in[7] + (L_ * 2 + 0) * 1024;
    LAS float* RW = (LAS float*)F.lds;
    LAS int* INFO_E = (LAS int*)(F.lds + 81920); LAS float* INFO_W0 = (LAS float*)(F.lds + 81920 + 2048); LAS float* INFO_W1 = (LAS float*)(F.lds + 81920 + 4096);
    LAS int* RANK = (LAS int*)(F.lds + 81920 + 6144); LAS int* CNTL = (LAS int*)(F.lds + 81920 + 8192); LAS int* BASEL = CNTL + 16;
    { const float* rg = A.in[20] + (size_t)L_ * 1024 * 4; const float* re = A.in[21] + (size_t)L_ * 1024 * 16;
      for (int idx = F.tid; idx < 1024 * 4; idx += NTHR) RW[(idx & 3) * 1024 + (idx >> 2)] = rg[idx];
      for (int idx = F.tid; idx < 1024 * 16; idx += NTHR) RW[(4 + (idx & 15)) * 1024 + (idx >> 4)] = re[idx]; }
    if (F.tid < 16) CNTL[F.tid] = 0;
    __syncthreads();
    const int RPB = (nrows + F.G - 1) / F.G, r0 = F.vcu * RPB, nloc = min(RPB, max(0, nrows - r0));
    f32x4 hN[4]; v2u hB[4], oN[4];
    if (F.wave < nloc) { const int r = r0 + F.wave; const float* hin = r < NL ? hin_lat + (size_t)r * 1024 : hin_ctx + (size_t)(r - NL) * 1024;
#pragma unroll
        for (int j = 0; j < 4; ++j) { const int cc = 4 * F.lane + 256 * j; if (L_ == 0) hN[j] = *(const f32x4*)(hin + cc); else hB[j] = *(const v2u*)(HB + (size_t)r * 1024 + cc); oN[j] = *(const v2u*)(O + (size_t)r * 1024 + cc); } }
    f32x4 lg[4], lb[4], mg2[4], mm4[4], mm3[4]; int cur_mr = -1;
#pragma unroll
    for (int j = 0; j < 4; ++j) { const int cc = 4 * F.lane + 256 * j; lg[j] = *(const f32x4*)(lng + cc); lb[j] = *(const f32x4*)(lnb + cc); }
    for (int rl = F.wave; rl < nloc; rl += NWAVES) {
        const int r = r0 + rl;
        bf16* hout = dry ? (bf16*)(ws + WS_CAT) + (size_t)r * 1024 : HB + (size_t)r * 1024;
        const int mr = mod_row(r);
        if (mr != cur_mr) { cur_mr = mr; const float* m = MOD + (size_t)(L_ * 17 + mr) * 6144;
#pragma unroll
            for (int j = 0; j < 4; ++j) { const int cc = 4 * F.lane + 256 * j; mg2[j] = *(const f32x4*)(m + 2048 + cc); mm4[j] = *(const f32x4*)(m + 4096 + cc) + 1.0f; mm3[j] = *(const f32x4*)(m + 3072 + cc); } }
        f32x4 v[4]; float s = 0.f;
#pragma unroll
        for (int j = 0; j < 4; ++j) { const v2u ob = oN[j];
            f32x4 o4; o4[0] = __uint_as_float(ob.x << 16); o4[1] = __uint_as_float(ob.x & 0xffff0000u); o4[2] = __uint_as_float(ob.y << 16); o4[3] = __uint_as_float(ob.y & 0xffff0000u);
            v[j] = (L_ == 0 ? hN[j] : unpk4(hB[j])) * ALPHA + mg2[j] * o4; s += (v[j][0] + v[j][1]) + (v[j][2] + v[j][3]); }
        const float mean = wave_sum(s) * (1.f / 1024.f); float q = 0.f;
#pragma unroll
        for (int j = 0; j < 4; ++j) { v[j] = v[j] - mean; q += (v[j][0] * v[j][0] + v[j][1] * v[j][1]) + (v[j][2] * v[j][2] + v[j][3] * v[j][3]); }
        const float rstd = rsqrtf(wave_sum(q) * (1.f / 1024.f) + LN_EPS);
#pragma unroll
        for (int j = 0; j < 4; ++j) { const int cc = 4 * F.lane + 256 * j;
            const f32x4 h1 = v[j] * rstd * lg[j] + lb[j];
            { v2u hb; hb.x = pk2(h1[0], h1[1]); hb.y = pk2(h1[2], h1[3]); *(v2u*)(hout + cc) = hb; }
            const f32x4 tt = h1 * mm4[j] + mm3[j];
            v2u o; o.x = pk2(tt[0], tt[1]); o.y = pk2(tt[2], tt[3]); *(v2u*)(ACT + (size_t)r * 1024 + cc) = o;
            v[j] = tt; }
        if (rl + NWAVES < nloc) { const int rn = r + NWAVES; const float* hin = rn < NL ? hin_lat + (size_t)rn * 1024 : hin_ctx + (size_t)(rn - NL) * 1024;
#pragma unroll
            for (int j = 0; j < 4; ++j) { const int cc = 4 * F.lane + 256 * j; if (L_ == 0) hN[j] = *(const f32x4*)(hin + cc); else hB[j] = *(const v2u*)(HB + (size_t)rn * 1024 + cc); oN[j] = *(const v2u*)(O + (size_t)rn * 1024 + cc); } }
        float G[4], E4[4];
        { float pa[4];
#pragma unroll
          for (int k = 0; k < 4; ++k) { f32x4 a = {0.f, 0.f, 0.f, 0.f};
#pragma unroll
              for (int j = 0; j < 4; ++j) a += v[j] * *(const LAS f32x4*)(RW + k * 1024 + 4 * F.lane + 256 * j);
              pa[k] = (a[0] + a[1]) + (a[2] + a[3]); }
          const bool u5 = (F.lane & 32) != 0, u4 = (F.lane & 16) != 0;
          const float q0 = (u5 ? pa[2] : pa[0]) + __shfl_xor(u5 ? pa[0] : pa[2], 32), q1 = (u5 ? pa[3] : pa[1]) + __shfl_xor(u5 ? pa[1] : pa[3], 32);
          float q = (u4 ? q1 : q0) + __shfl_xor(u4 ? q0 : q1, 16);
          q += __shfl_xor(q, 8); q += __shfl_xor(q, 4); q += __shfl_xor(q, 2); q += __shfl_xor(q, 1);
#pragma unroll
          for (int k = 0; k < 4; ++k) G[k] = __int_as_float(__builtin_amdgcn_readlane(__float_as_int(q), 16 * k)); }
        int gi = 0; float gm = G[0];
#pragma unroll
        for (int i = 1; i < 4; ++i) if (G[i] > gm) { gm = G[i]; gi = i; }
        float gs = 0.f;
#pragma unroll
        for (int i = 0; i < 4; ++i) gs += __expf(G[i] - gm);
        const float gp = __builtin_amdgcn_rcpf(gs);
        { float pa[4]; const LAS float* RWg = RW + (4 + 4 * gi) * 1024;
#pragma unroll
          for (int k = 0; k < 4; ++k) { f32x4 a = {0.f, 0.f, 0.f, 0.f};
#pragma unroll
              for (int j = 0; j < 4; ++j) a += v[j] * *(const LAS f32x4*)(RWg + k * 1024 + 4 * F.lane + 256 * j);
              pa[k] = (a[0] + a[1]) + (a[2] + a[3]); }
          const bool u5 = (F.lane & 32) != 0, u4 = (F.lane & 16) != 0;
          const float q0 = (u5 ? pa[2] : pa[0]) + __shfl_xor(u5 ? pa[0] : pa[2], 32), q1 = (u5 ? pa[3] : pa[1]) + __shfl_xor(u5 ? pa[1] : pa[3], 32);
          float q = (u4 ? q1 : q0) + __shfl_xor(u4 ? q0 : q1, 16);
          q += __shfl_xor(q, 8); q += __shfl_xor(q, 4); q += __shfl_xor(q, 2); q += __shfl_xor(q, 1);
#pragma unroll
          for (int k = 0; k < 4; ++k) E4[k] = __int_as_float(__builtin_amdgcn_readlane(__float_as_int(q), 16 * k)); }
        int i0 = 0; float e0 = E4[0];
#pragma unroll
        for (int i = 1; i < 4; ++i) if (E4[i] > e0) { e0 = E4[i]; i0 = i; }
        int i1 = 0; float e1 = -3e38f;
#pragma unroll
        for (int i = 0; i < 4; ++i) if (i != i0 && E4[i] > e1) { e1 = E4[i]; i1 = i; }
        const float x1 = __expf(e1 - e0), rx = gp * __builtin_amdgcn_rcpf(1.f + x1);
        if (F.lane == 0) { INFO_E[rl] = (gi * 4 + i0) | ((gi * 4 + i1) << 8); INFO_W0[rl] = rx; INFO_W1[rl] = rx * x1; }
    }
    __syncthreads();
    for (int rl = F.tid; rl < nloc; rl += NTHR) { const int ee = INFO_E[rl];
        const int k0 = __hip_atomic_fetch_add(CNTL + (ee & 255), 1, __ATOMIC_RELAXED, __HIP_MEMORY_SCOPE_WORKGROUP);
        const int k1 = __hip_atomic_fetch_add(CNTL + (ee >> 8), 1, __ATOMIC_RELAXED, __HIP_MEMORY_SCOPE_WORKGROUP);
        RANK[rl] = k0 | (k1 << 16); }
    __syncthreads();
    if (dry) return;
    if (F.tid < 16) BASEL[F.tid] = (int)__hip_atomic_fetch_add(F.ctl + CW_CNT + L_ * 64 + F.tid, (unsigned)CNTL[F.tid], RLX_AGENT);
    __syncthreads();
    int* LIST = (int*)(ws + WS_LIST); float* LISTW = (float*)(ws + WS_LISTW);
    for (int rl = F.tid; rl < nloc; rl += NTHR) { const int ee = INFO_E[rl], rk = RANK[rl], e0 = ee & 255, e1 = ee >> 8; const int s = (r0 + rl) * 2;
        const size_t i0 = (size_t)e0 * pg8::MOE_CAP + BASEL[e0] + (rk & 0xffff), i1 = (size_t)e1 * pg8::MOE_CAP + BASEL[e1] + (rk >> 16);
        LIST[i0] = s; LISTW[i0] = INFO_W0[rl]; LIST[i1] = s + 1; LISTW[i1] = INFO_W1[rl]; }
}

template <int L_> __device__ __forceinline__ void phase_ln2(Frame& F, const Args& A, bool dry) {
    bf16* HB = (bf16*)(A.ws + WS_HB);
    constexpr int nrows = L_ == 0 ? NT : NL;
    unsigned char* ws = A.ws;
    const float* MOD = (const float*)(ws + WS_MOD); const bf16* YP = (const bf16*)(ws + WS_PROJ); bf16* ACT = (bf16*)(ws + WS_ACT);
    const float* lng = A.in[6] + (L_ * 2 + 1) * 1024; const float* lnb = A.in[7] + (L_ * 2 + 1) * 1024;
    const int RPB = (nrows + F.G - 1) / F.G, r0 = F.vcu * RPB, nloc = min(RPB, max(0, nrows - r0));
    v2u hB[4], yN[4], zN[4];
    if (F.wave < nloc) { const int r = r0 + F.wave;
#pragma unroll
        for (int j = 0; j < 4; ++j) { const int cc = 4 * F.lane + 256 * j; hB[j] = *(const v2u*)(HB + (size_t)r * 1024 + cc); yN[j] = *(const v2u*)(YP + (size_t)r * 1024 + cc); zN[j] = *(const v2u*)(YP + ((size_t)NT + r) * 1024 + cc); } }
    f32x4 lg[4], lb[4], mg5[4], ms1[4], mh0[4]; int cur_mr = -1;
#pragma unroll
    for (int j = 0; j < 4; ++j) { const int cc = 4 * F.lane + 256 * j; lg[j] = *(const f32x4*)(lng + cc); lb[j] = *(const f32x4*)(lnb + cc); }
    for (int rl = F.wave; rl < nloc; rl += NWAVES) {
        const int r = r0 + rl;
        const int mr = mod_row(r);
        if (mr != cur_mr) { cur_mr = mr; const float* m = MOD + (size_t)(L_ * 17 + mr) * 6144; const float* m1 = MOD + (size_t)(1 * 17 + mr) * 6144;
#pragma unroll
            for (int j = 0; j < 4; ++j) { const int cc = 4 * F.lane + 256 * j; mg5[j] = *(const f32x4*)(m + 5120 + cc); ms1[j] = *(const f32x4*)(m1 + 1024 + cc) + 1.0f; mh0[j] = *(const f32x4*)(m1 + cc); } }
        f32x4 v[4]; float s = 0.f;
#pragma unroll
        for (int j = 0; j < 4; ++j) { const v2u y0 = yN[j], y1 = zN[j];
            f32x4 y4; y4[0] = __uint_as_float(y0.x << 16) + __uint_as_float(y1.x << 16); y4[1] = __uint_as_float(y0.x & 0xffff0000u) + __uint_as_float(y1.x & 0xffff0000u);
            y4[2] = __uint_as_float(y0.y << 16) + __uint_as_float(y1.y << 16); y4[3] = __uint_as_float(y0.y & 0xffff0000u) + __uint_as_float(y1.y & 0xffff0000u);
            v[j] = unpk4(hB[j]) * ALPHA + mg5[j] * y4; s += (v[j][0] + v[j][1]) + (v[j][2] + v[j][3]); }
        if (rl + NWAVES < nloc) { const int rn = r + NWAVES;
#pragma unroll
            for (int j = 0; j < 4; ++j) { const int cc = 4 * F.lane + 256 * j; hB[j] = *(const v2u*)(HB + (size_t)rn * 1024 + cc); yN[j] = *(const v2u*)(YP + (size_t)rn * 1024 + cc); zN[j] = *(const v2u*)(YP + ((size_t)NT + rn) * 1024 + cc); } }
        const float mean = wave_sum(s) * (1.f / 1024.f); float q = 0.f;
#pragma unroll
        for (int j = 0; j < 4; ++j) { v[j] = v[j] - mean; q += (v[j][0] * v[j][0] + v[j][1] * v[j][1]) + (v[j][2] * v[j][2] + v[j][3] * v[j][3]); }
        const float rstd = rsqrtf(wave_sum(q) * (1.f / 1024.f) + LN_EPS);
#pragma unroll
        for (int j = 0; j < 4; ++j) { const int cc = 4 * F.lane + 256 * j;
            const f32x4 h2 = v[j] * rstd * lg[j] + lb[j];
            if (L_ == 1) { *(f32x4*)((dry ? (float*)(ws + WS_CAT) + (size_t)(r & 16383) * 1024 : A.out + (size_t)r * 1024) + cc) = h2; }
            else { v2u hb; hb.x = pk2(h2[0], h2[1]); hb.y = pk2(h2[2], h2[3]); *(v2u*)((dry ? (bf16*)(ws + WS_CAT) : HB) + (size_t)r * 1024 + cc) = hb; }
            if (L_ == 0) { const f32x4 u = h2 * ms1[j] + mh0[j];
                v2u o; o.x = pk2(u[0], u[1]); o.y = pk2(u[2], u[3]); *(v2u*)(ACT + (size_t)r * 1024 + cc) = o; } }
    }
}

namespace att {
typedef short bf16x8 __attribute__((ext_vector_type(8)));
typedef float f32x16 __attribute__((ext_vector_type(16)));
typedef short s16x4 __attribute__((ext_vector_type(4)));
constexpr float LOG2E = 1.4426950408889634f, C2 = 0.125f * LOG2E;
constexpr int A_KV = 0;
constexpr int A_BT = 133120;
constexpr int A_WSF = 149504;
__device__ __forceinline__ int crow(int r, int hi) { return (r & 3) + 8 * (r >> 2) + 4 * hi; }
__device__ __forceinline__ s16x4 vtr(const LAS char* p) { return __builtin_bit_cast(s16x4, __builtin_amdgcn_ds_read_tr16_b64_v4i16((LAS s16x4*)p)); }
__device__ __forceinline__ unsigned cvtpk(float lo, float hi) { typedef float f2 __attribute__((ext_vector_type(2))); typedef __bf16 b2 __attribute__((ext_vector_type(2)));
    f2 v = {lo, hi}; b2 b = __builtin_convertvector(v, b2); return __builtin_bit_cast(unsigned, b); }

template <int NH> __device__ __forceinline__ void stage_dma(const bf16* base, int ld, int row0, int kcol0, int vcol0, LAS unsigned char* buf, int lane, int wave) {
    const bf16* kp = base + (size_t)(row0 + wave * 8 + (lane >> 3)) * ld + kcol0 + (((lane & 7) ^ ((4 * wave + (lane >> 4)) & 7)) << 3);
    const bf16* vp = base + (size_t)(row0 + 16 * (wave & 3) + (lane >> 2)) * ld + vcol0 + (wave >> 2) * 32 + (lane & 3) * 8;
#pragma unroll
    for (int hh = 0; hh < NH; ++hh) {
        __builtin_amdgcn_global_load_lds((const unsigned*)(kp + hh * 64), (LAS unsigned*)(buf + hh * 16384 + wave * 1024), 16, 0, 0);
        __builtin_amdgcn_global_load_lds((const unsigned*)(vp + hh * 64), (LAS unsigned*)(buf + hh * 16384 + 8192 + wave * 1024), 16, 0, 0);
    }
}
#define ATT_DRAIN_BAR() do { asm volatile("s_waitcnt vmcnt(0)" ::: "memory"); __syncthreads(); } while (0)

template <int KIND, bool NEGM, int EV = 0> __device__ __forceinline__ void att_step(const LAS unsigned char* img, const bf16x8 (&qr)[4], f32x16 (&o)[2], float& m, float& l, LAS float* wsf,
                                                            int r32, int hi, int lane, f32x16& negm, const f32x16& mi0, const f32x16& mi1, const LAS float* btl, int dq) {
    f32x16 p0, p1;
    const LAS unsigned char* kb = img + r32 * 128;
    bf16x8 kf[8];
#define ATT_KLOAD(d0_) { const unsigned ka = (unsigned)(__UINTPTR_TYPE__)kb + (unsigned)(((2 * (d0_) + hi) ^ ((r32 >> 1) & 7)) << 4); \
        asm volatile("ds_read_b128 %0, %1" : "=v"(kf[2 * (d0_)]) : "v"(ka) : "memory"); asm volatile("ds_read_b128 %0, %1 offset:4096" : "=v"(kf[2 * (d0_) + 1]) : "v"(ka) : "memory"); }
#define ATT_LGKM(n_) do { asm volatile("s_waitcnt lgkmcnt(" #n_ ")" ::: "memory"); __builtin_amdgcn_sched_barrier(0); } while (0)
    ATT_KLOAD(0) ATT_KLOAD(1)
    ATT_LGKM(2);
    p0 = __builtin_amdgcn_mfma_f32_32x32x16_bf16(kf[0], qr[0], NEGM ? negm : mi0, 0, 0, 0); p1 = __builtin_amdgcn_mfma_f32_32x32x16_bf16(kf[1], qr[0], NEGM ? negm : mi1, 0, 0, 0);
    ATT_KLOAD(2)
    ATT_LGKM(2);
    p0 = __builtin_amdgcn_mfma_f32_32x32x16_bf16(kf[2], qr[1], p0, 0, 0, 0); p1 = __builtin_amdgcn_mfma_f32_32x32x16_bf16(kf[3], qr[1], p1, 0, 0, 0);
    ATT_KLOAD(3)
    ATT_LGKM(2);
    p0 = __builtin_amdgcn_mfma_f32_32x32x16_bf16(kf[4], qr[2], p0, 0, 0, 0); p1 = __builtin_amdgcn_mfma_f32_32x32x16_bf16(kf[5], qr[2], p1, 0, 0, 0);
    ATT_LGKM(0);
    p0 = __builtin_amdgcn_mfma_f32_32x32x16_bf16(kf[6], qr[3], p0, 0, 0, 0); p1 = __builtin_amdgcn_mfma_f32_32x32x16_bf16(kf[7], qr[3], p1, 0, 0, 0);
#undef ATT_KLOAD
    if (KIND == 1) {
        const unsigned ba = (unsigned)(__UINTPTR_TYPE__)btl;
        typedef float f32x2_t __attribute__((ext_vector_type(2)));
        f32x2_t bt[16];
#pragma unroll
        for (int g = 0; g < 8; ++g) { asm volatile("ds_read2_b32 %0, %1 offset0:%c2 offset1:%c3" : "=v"(bt[g]) : "v"(ba), "i"((2 * g & 3) + 8 * (g >> 1)), "i"((2 * g & 3) + 8 * (g >> 1) + 1) : "memory");
                                      asm volatile("ds_read2_b32 %0, %1 offset0:%c2 offset1:%c3" : "=v"(bt[8 + g]) : "v"(ba), "i"((2 * g & 3) + 8 * (g >> 1) + 32), "i"((2 * g & 3) + 8 * (g >> 1) + 33) : "memory"); }
        ATT_LGKM(0);
#pragma unroll
        for (int r = 0; r < 16; ++r) { p0[r] += bt[r >> 1][r & 1]; p1[r] += bt[8 + (r >> 1)][r & 1]; }
    } else if (KIND == 2) {
#pragma unroll
        for (int r = 0; r < 16; ++r) { const int k0 = (r & 3) + 8 * (r >> 2) + 4 * hi, k1 = k0 + 32;
            p0[r] = ((unsigned)(dq - k0 + 128) <= 256u) ? p0[r] : -INFINITY; p1[r] = ((unsigned)(dq - k1 + 128) <= 256u) ? p1[r] : -INFINITY; }
    }
    float pinf = INFINITY; asm volatile("" : "+s"(pinf));
    float rm = __builtin_amdgcn_fmed3f(p0[0], p1[0], pinf);
#pragma unroll
    for (int r = 1; r < 16; ++r) rm = fmaxf(rm, __builtin_amdgcn_fmed3f(p0[r], p1[r], pinf));
    rm = fmaxf(rm, __shfl_xor(rm, 32));
    if (NEGM) {
        if (__any(rm > 8.0f)) {
            const float dl = fmaxf(rm, 0.f), f = __builtin_amdgcn_exp2f(-dl);
            m += dl; l *= f; wsf[r32] = f;
#pragma unroll
            for (int r = 0; r < 16; ++r) { p0[r] -= dl; p1[r] -= dl; negm[r] -= dl; }
#pragma unroll
            for (int r = 0; r < 16; ++r) { const float fr = wsf[crow(r, hi)]; o[0][r] *= fr; o[1][r] *= fr; }
        }
    } else {
        if (__any(rm > m + 8.0f)) {
            const float mn = fmaxf(m, rm), f = __builtin_amdgcn_exp2f(m - mn);
            l *= f; m = mn; wsf[r32] = f;
#pragma unroll
            for (int r = 0; r < 16; ++r) { const float fr = wsf[crow(r, hi)]; o[0][r] *= fr; o[1][r] *= fr; }
        }
    }
    const int vb = (int)(unsigned)(__UINTPTR_TYPE__)(img + 8192) + ((lane >> 4) & 1) * 32 + (lane & 3) * 8 + (4 * hi + ((lane & 15) >> 2)) * 64;
    s16x4 lo[4], hh[4];
#pragma unroll
    for (int ks = 0; ks < EV; ++ks) {
        asm volatile("ds_read_b64_tr_b16 %0, %1 offset:%c2" : "=&v"(lo[ks]) : "v"(vb), "i"(ks * 1024) : "memory");
        asm volatile("ds_read_b64_tr_b16 %0, %1 offset:%c2" : "=&v"(hh[ks]) : "v"(vb), "i"(ks * 1024 + 512) : "memory"); }
    if (EV > 0) __builtin_amdgcn_sched_barrier(0);
    float sacc = 0.f;
#pragma unroll
    for (int r = 0; r < 16; ++r) { p0[r] = __builtin_amdgcn_exp2f(NEGM ? p0[r] : p0[r] - m); p1[r] = __builtin_amdgcn_exp2f(NEGM ? p1[r] : p1[r] - m); sacc += p0[r] + p1[r]; }
    l += sacc;
    v4u pw[4];
#pragma unroll
    for (int q = 0; q < 4; ++q) { pw[0][q] = cvtpk(p0[2 * q], p0[2 * q + 1]); pw[1][q] = cvtpk(p0[8 + 2 * q], p0[9 + 2 * q]);
                                  pw[2][q] = cvtpk(p1[2 * q], p1[2 * q + 1]); pw[3][q] = cvtpk(p1[8 + 2 * q], p1[9 + 2 * q]); }
    if (EV > 0) __builtin_amdgcn_sched_barrier(0);
#pragma unroll
    for (int ks = EV; ks < 4; ++ks) {
        asm volatile("ds_read_b64_tr_b16 %0, %1 offset:%c2" : "=&v"(lo[ks]) : "v"(vb), "i"(ks * 1024) : "memory");
        asm volatile("ds_read_b64_tr_b16 %0, %1 offset:%c2" : "=&v"(hh[ks]) : "v"(vb), "i"(ks * 1024 + 512) : "memory"); }
    if (EV > 0 && EV < 4) {
        asm volatile("s_waitcnt lgkmcnt(%c0)" :: "i"(2 * (4 - EV)) : "memory"); __builtin_amdgcn_sched_barrier(0);
#pragma unroll
        for (int ks = 0; ks < EV; ++ks) {
            const bf16x8 vf = {lo[ks][0], lo[ks][1], lo[ks][2], lo[ks][3], hh[ks][0], hh[ks][1], hh[ks][2], hh[ks][3]};
            o[0] = __builtin_amdgcn_mfma_f32_32x32x16_bf16(__builtin_bit_cast(bf16x8, pw[ks]), vf, o[0], 0, 0, 0); }
    }
    asm volatile("s_waitcnt lgkmcnt(0)" ::: "memory"); __builtin_amdgcn_sched_barrier(0);
#pragma unroll
    for (int ks = (EV > 0 && EV < 4) ? EV : 0; ks < 4; ++ks) {
        const bf16x8 vf = {lo[ks][0], lo[ks][1], lo[ks][2], lo[ks][3], hh[ks][0], hh[ks][1], hh[ks][2], hh[ks][3]};
        o[0] = __builtin_amdgcn_mfma_f32_32x32x16_bf16(__builtin_bit_cast(bf16x8, pw[ks]), vf, o[0], 0, 0, 0); }
    __builtin_amdgcn_sched_barrier(0);
#pragma unroll
    for (int ks = 0; ks < 4; ++ks) {
        asm volatile("ds_read_b64_tr_b16 %0, %1 offset:%c2" : "=&v"(lo[ks]) : "v"(vb), "i"(4096 + ks * 1024) : "memory");
        asm volatile("ds_read_b64_tr_b16 %0, %1 offset:%c2" : "=&v"(hh[ks]) : "v"(vb), "i"(4096 + ks * 1024 + 512) : "memory"); }
    asm volatile("s_waitcnt lgkmcnt(0)" ::: "memory"); __builtin_amdgcn_sched_barrier(0);
#pragma unroll
    for (int ks = 0; ks < 4; ++ks) {
        const bf16x8 vf = {lo[ks][0], lo[ks][1], lo[ks][2], lo[ks][3], hh[ks][0], hh[ks][1], hh[ks][2], hh[ks][3]};
        o[1] = __builtin_amdgcn_mfma_f32_32x32x16_bf16(__builtin_bit_cast(bf16x8, pw[ks]), vf, o[1], 0, 0, 0); }
}
__device__ __forceinline__ void att_store(const f32x16 (&o)[2], float l, LAS float* wsf, LAS unsigned char* stgb, bf16* O, int ldo, int orow_base, int ocol, int r32, int hi, int lane, bool pair16 = false) {
    const float lt = l + __shfl_xor(l, 32);
    wsf[r32] = __builtin_amdgcn_rcpf(lt);
    LAS bf16* stg = (LAS bf16*)stgb;
#pragma unroll
    for (int r = 0; r < 16; ++r) { const int orow = crow(r, hi); const float rl = wsf[orow];
        stg[orow * 64 + r32] = (bf16)pk2(o[0][r] * rl, 0.f); stg[orow * 64 + 32 + r32] = (bf16)pk2(o[1][r] * rl, 0.f); }
#pragma unroll
    for (int i = 0; i < 4; ++i) { const int row = i * 8 + (lane >> 3), ch = lane & 7;
        const v4u v = *(const LAS v4u*)(stg + row * 64 + ch * 8);
        *(v4u*)(O + (size_t)(orow_base + row + (pair16 ? (row >> 4) * 48 : 0)) * ldo + ocol + ch * 8) = v; }
}

template <bool NA> __device__ __forceinline__ void na_unit(Frame& F, const bf16* P, const float* rpb, bf16* CAT, int b, int gr, int hg, bool nodma = false) {
    const int lane = F.lane, wave = F.wave, r32 = lane & 31, hi = lane >> 5, hsel = wave >> 1, half = wave & 1, h = hg * 4 + hsel;
    const int rs = min(max(gr - 4, 0), 24);
    const int qrow0 = (NA ? b * 2048 + gr * 64 : NL + b * 256 + gr * 64) + 32 * half;
    LAS float* wsf = (LAS float*)(F.lds + A_WSF) + wave * 64;
    LAS float* BT = (LAS float*)(F.lds + A_BT);
    constexpr int NS = NA ? 12 : 4;
    bf16x8 qr[4];
#pragma unroll
    for (int d0 = 0; d0 < 4; ++d0) qr[d0] = *(const bf16x8*)(P + (size_t)(qrow0 + r32) * 2560 + 1024 + h * 64 + d0 * 16 + hi * 8);
    f32x16 o[2];
#pragma unroll
    for (int r = 0; r < 16; ++r) { o[0][r] = 0.f; o[1][r] = 0.f; }
    float m = -1e30f, l = 0.f;
    const int j = 32 * half + r32;
    f32x16 mi0, mi1, negm;
    { const int cs = min(max(j - 8, 0), 48);
#pragma unroll
      for (int r = 0; r < 16; ++r) { const int k0 = (r & 3) + 8 * (r >> 2) + 4 * hi; negm[r] = 0.f; mi0[r] = (!NA || (unsigned)(k0 - cs) < 16u) ? 0.f : -INFINITY; mi1[r] = (!NA || (unsigned)(k0 + 32 - cs) < 16u) ? 0.f : -INFINITY; } }
    f32x16 zz;
#pragma unroll
    for (int r = 0; r < 16; ++r) zz[r] = 0.f;
    __syncthreads();
    if (NA) for (int idx = F.tid; idx < 4096; idx += NTHR) { const int hh = idx >> 10, ii = (idx >> 7) & 7, y = (idx & 127) - 48;
        BT[idx] = (y >= 0 && y <= 30) ? rpb[((hg * 4 + hh) * 15 + (rs + ii - gr + 7)) * 31 + y] * LOG2E : 0.f; }
    stage_dma<4>(P, 2560, NL + b * 256, 1536 + hg * 256, 2048 + hg * 256, F.lds + A_KV, lane, wave);
    ATT_DRAIN_BAR();
    const LAS float* btl0 = BT + hsel * 1024 + (4 * hi - j + 63);
    for (int t = 0; t < NS; ++t) {
        const LAS unsigned char* img = F.lds + A_KV + (t & 1) * 65536 + hsel * 16384;
        if (t + 1 < NS && !nodma) { const int row0 = (t + 1 < 4) ? NL + b * 256 + 64 * (t + 1) : b * 2048 + (rs + t + 1 - 4) * 64;
            stage_dma<4>(P, 2560, row0, 1536 + hg * 256, 2048 + hg * 256, F.lds + A_KV + ((t + 1) & 1) * 65536, lane, wave); }
        if (t < 4) att_step<0, false, 4>(img, qr, o, m, l, wsf, r32, hi, lane, negm, zz, zz, nullptr, 0);
        else att_step<1, false, 4>(img, qr, o, m, l, wsf, r32, hi, lane, negm, mi0, mi1, btl0 + (t - 4) * 128, 0);
        ATT_DRAIN_BAR();
    }
    att_store(o, l, wsf, F.lds + A_KV + wave * 4096, CAT, 1024, qrow0, 512 + h * 64, r32, hi, lane);
}

__device__ __forceinline__ void att_step32(const LAS unsigned char* img, int W0, const bf16x8 (&qr)[4], f32x16 (&o)[2], float& m, float& l, LAS float* wsf,
                                           int r32, int hi, int lane, const f32x16& mi, const LAS float* btl, bool rowok) {
    f32x16 p0;
    const unsigned kb = (unsigned)(__UINTPTR_TYPE__)(img + (W0 + r32) * 128); const int sw = ((W0 + r32) >> 1) & 7;
    bf16x8 kf[4];
#pragma unroll
    for (int d0 = 0; d0 < 4; ++d0) { const unsigned ka = kb + (unsigned)(((2 * d0 + hi) ^ sw) << 4); asm volatile("ds_read_b128 %0, %1" : "=v"(kf[d0]) : "v"(ka) : "memory"); }
    ATT_LGKM(3);
    p0 = __builtin_amdgcn_mfma_f32_32x32x16_bf16(kf[0], qr[0], mi, 0, 0, 0);
    ATT_LGKM(2);
    p0 = __builtin_amdgcn_mfma_f32_32x32x16_bf16(kf[1], qr[1], p0, 0, 0, 0);
    ATT_LGKM(1);
    p0 = __builtin_amdgcn_mfma_f32_32x32x16_bf16(kf[2], qr[2], p0, 0, 0, 0);
    const unsigned ba = (unsigned)(__UINTPTR_TYPE__)btl;
    typedef float f32x2_t __attribute__((ext_vector_type(2)));
    f32x2_t bt[8];
#pragma unroll
    for (int g = 0; g < 8; ++g) asm volatile("ds_read2_b32 %0, %1 offset0:%c2 offset1:%c3" : "=v"(bt[g]) : "v"(ba), "i"((2 * g & 3) + 8 * (g >> 1)), "i"((2 * g & 3) + 8 * (g >> 1) + 1) : "memory");
    ATT_LGKM(8);
    p0 = __builtin_amdgcn_mfma_f32_32x32x16_bf16(kf[3], qr[3], p0, 0, 0, 0);
    ATT_LGKM(0);
#pragma unroll
    for (int r = 0; r < 16; ++r) { const float x = p0[r] + bt[r >> 1][r & 1]; p0[r] = rowok ? x : -INFINITY; }
    float pinf = INFINITY; asm volatile("" : "+s"(pinf));
    float rm = __builtin_amdgcn_fmed3f(p0[0], p0[1], pinf);
#pragma unroll
    for (int r = 1; r < 8; ++r) rm = fmaxf(rm, __builtin_amdgcn_fmed3f(p0[2 * r], p0[2 * r + 1], pinf));
    rm = fmaxf(rm, __shfl_xor(rm, 32));
    if (__any(rm > m + 8.0f)) {
        const float mn = fmaxf(m, rm), f = __builtin_amdgcn_exp2f(m - mn);
        l *= f; m = mn; wsf[r32] = f;
#pragma unroll
        for (int r = 0; r < 16; ++r) { const float fr = wsf[crow(r, hi)]; o[0][r] *= fr; o[1][r] *= fr; }
    }
    const int vb = (int)(unsigned)(__UINTPTR_TYPE__)(img + 8192) + ((lane >> 4) & 1) * 32 + (lane & 3) * 8 + (W0 + 4 * hi + ((lane & 15) >> 2)) * 64;
    s16x4 lo[4], hh[4];
#pragma unroll
    for (int ks = 0; ks < 2; ++ks) {
        asm volatile("ds_read_b64_tr_b16 %0, %1 offset:%c2" : "=&v"(lo[ks]) : "v"(vb), "i"(ks * 1024) : "memory");
        asm volatile("ds_read_b64_tr_b16 %0, %1 offset:%c2" : "=&v"(hh[ks]) : "v"(vb), "i"(ks * 1024 + 512) : "memory"); }
    __builtin_amdgcn_sched_barrier(0);
    float sacc = 0.f;
#pragma unroll
    for (int r = 0; r < 16; ++r) { p0[r] = __builtin_amdgcn_exp2f(p0[r] - m); sacc += p0[r]; }
    l += sacc;
    v4u pw[2];
#pragma unroll
    for (int q = 0; q < 4; ++q) { pw[0][q] = cvtpk(p0[2 * q], p0[2 * q + 1]); pw[1][q] = cvtpk(p0[8 + 2 * q], p0[9 + 2 * q]); }
    __builtin_amdgcn_sched_barrier(0);
#pragma unroll
    for (int ks = 0; ks < 2; ++ks) {
        asm volatile("ds_read_b64_tr_b16 %0, %1 offset:%c2" : "=&v"(lo[2 + ks]) : "v"(vb), "i"(4096 + ks * 1024) : "memory");
        asm volatile("ds_read_b64_tr_b16 %0, %1 offset:%c2" : "=&v"(hh[2 + ks]) : "v"(vb), "i"(4096 + ks * 1024 + 512) : "memory"); }
    ATT_LGKM(4);
#pragma unroll
    for (int ks = 0; ks < 2; ++ks) {
        const bf16x8 vf = {lo[ks][0], lo[ks][1], lo[ks][2], lo[ks][3], hh[ks][0], hh[ks][1], hh[ks][2], hh[ks][3]};
        o[0] = __builtin_amdgcn_mfma_f32_32x32x16_bf16(__builtin_bit_cast(bf16x8, pw[ks]), vf, o[0], 0, 0, 0); }
    ATT_LGKM(0);
#pragma unroll
    for (int ks = 0; ks < 2; ++ks) {
        const bf16x8 vf = {lo[2 + ks][0], lo[2 + ks][1], lo[2 + ks][2], lo[2 + ks][3], hh[2 + ks][0], hh[2 + ks][1], hh[2 + ks][2], hh[2 + ks][3]};
        o[1] = __builtin_amdgcn_mfma_f32_32x32x16_bf16(__builtin_bit_cast(bf16x8, pw[ks]), vf, o[1], 0, 0, 0); }
    __builtin_amdgcn_sched_barrier(0);
}
constexpr int A_BT2 = 133120;
__device__ __forceinline__ void na_pair_unit(Frame& F, const bf16* P, const float* rpb, bf16* CAT, int b, int gp, int hp, bool nodma) {
    const int lane = F.lane, wave = F.wave, r32 = lane & 31, hi = lane >> 5, hsel = wave >> 2, g = wave & 3, h = hp * 2 + hsel;
    const int gr0 = gp * 2, rsel = r32 >> 4, colq = 16 * g + (r32 & 15), grl = gr0 + rsel;
    const int rsU = min(max(gr0 - 4, 0), 24), rsV = min(max(gr0 - 3, 0), 24), nrows = rsV + 8 - rsU, NS = 4 + nrows;
    const int rsl = rsel ? rsV : rsU;
    const int W0 = g == 0 ? 0 : g == 1 ? 8 : g == 2 ? 24 : 32;
    LAS float* wsf = (LAS float*)(F.lds + A_WSF) + wave * 64;
    LAS float* BT = (LAS float*)(F.lds + A_BT2);
    bf16x8 qr[4];
#pragma unroll
    for (int d0 = 0; d0 < 4; ++d0) qr[d0] = *(const bf16x8*)(P + (size_t)(b * 2048 + grl * 64 + colq) * 2560 + 1024 + h * 64 + d0 * 16 + hi * 8);
    f32x16 o[2], mi, zz, negm;
    { const int cs = min(max(colq - 8, 0), 48);
#pragma unroll
      for (int r = 0; r < 16; ++r) { o[0][r] = 0.f; o[1][r] = 0.f; zz[r] = 0.f; negm[r] = 0.f; const int kc = W0 + (r & 3) + 8 * (r >> 2) + 4 * hi; mi[r] = ((unsigned)(kc - cs) < 16u) ? 0.f : -INFINITY; } }
    float m = -1e30f, l = 0.f;
    __syncthreads();
    for (int idx = F.tid; idx < 2 * 15 * 64; idx += NTHR) { const int hh = idx / 960, ro = (idx / 64) % 15, y = (idx & 63) - 16;
        BT[idx] = (y >= 0 && y <= 30) ? rpb[((hp * 2 + hh) * 15 + ro) * 31 + y] * LOG2E : 0.f; }
#define NA_ROW0(tt) (((tt) < 4) ? NL + b * 256 + 64 * (tt) : b * 2048 + (rsU + (tt) - 4) * 64)
    stage_dma<2>(P, 2560, NA_ROW0(0), 1536 + hp * 128, 2048 + hp * 128, F.lds + A_KV, lane, wave);
    stage_dma<2>(P, 2560, NA_ROW0(1), 1536 + hp * 128, 2048 + hp * 128, F.lds + A_KV + 32768, lane, wave);
    asm volatile("s_waitcnt vmcnt(4) lgkmcnt(0)\n\ts_barrier" ::: "memory");
    const LAS float* btl0 = BT + hsel * 960 + (W0 + 4 * hi - colq + 31);
    int slot = 0;
    for (int t = 0; t < NS; ++t) {
        const LAS unsigned char* img = F.lds + A_KV + slot * 32768 + hsel * 16384;
        const int s2 = slot == 0 ? 2 : slot - 1;
        if (t + 2 < NS) stage_dma<2>(P, 2560, NA_ROW0(t + 2), 1536 + hp * 128, 2048 + hp * 128, F.lds + A_KV + s2 * 32768, lane, wave);
        if (t < 4) att_step<0, false, 4>(img, qr, o, m, l, wsf, r32, hi, lane, negm, zz, zz, nullptr, 0);
        else { const int wr = rsU + t - 4; const int ro = min(max(wr - grl + 7, 0), 14);
            att_step32(img, W0, qr, o, m, l, wsf, r32, hi, lane, mi, btl0 + ro * 64, (unsigned)(wr - rsl) < 8u); }
        if (t + 2 < NS) asm volatile("s_waitcnt vmcnt(4) lgkmcnt(0)\n\ts_barrier" ::: "memory");
        else asm volatile("s_waitcnt vmcnt(0) lgkmcnt(0)\n\ts_barrier" ::: "memory");
        slot = slot == 2 ? 0 : slot + 1;
    }
#undef NA_ROW0
    att_store(o, l, wsf, F.lds + A_KV + wave * 4096, CAT, 1024, b * 2048 + gr0 * 64 + 16 * g, 512 + h * 64, r32, hi, lane, true);
}

constexpr int W_CTX = 0, W_RING = 65536, W_STG = 151552;
__device__ __forceinline__ void win_super(Frame& F, const bf16* QKV, const float* sink, bf16* CAT, int b, int hkv, int qg) {
    const int lane = F.lane, wave = F.wave, r32 = lane & 31, hi = lane >> 5, hq = hkv * 4 + (wave >> 1), half = wave & 1;
    LAS float* wsf = (LAS float*)(F.lds + A_WSF) + wave * 64;
    LAS bf16* stg = (LAS bf16*)(F.lds + W_STG + wave * 1024);
    const int kcol = 1024 + hkv * 64, vcol = 1280 + hkv * 64, qb0 = qg * 8;
    f32x16 dummy;
#pragma unroll
    for (int r = 0; r < 16; ++r) dummy[r] = 0.f;
    __syncthreads();
#pragma unroll
    for (int t = 0; t < 4; ++t) stage_dma<1>(QKV, 1536, NL + b * 256 + 64 * t, kcol, vcol, F.lds + W_CTX + t * 16384, lane, wave);
    for (int jt = max(qb0 - 2, 0); jt <= min(qb0 + 2, 31); ++jt) stage_dma<1>(QKV, 1536, b * 2048 + jt * 64, kcol, vcol, F.lds + W_RING + (jt % 5) * 16384, lane, wave);
    bf16x8 qn[4];
#pragma unroll
    for (int d0 = 0; d0 < 4; ++d0) qn[d0] = *(const bf16x8*)(QKV + (size_t)(b * 2048 + qb0 * 64 + 32 * half + r32) * 1536 + hq * 64 + d0 * 16 + hi * 8);
    const float sk = sink[hq] * LOG2E;
    ATT_DRAIN_BAR();
    for (int i = 0; i < 8; ++i) {
        const int qb = qb0 + i, qrow0 = b * 2048 + qb * 64 + 32 * half, qpos = qb * 64 + 32 * half + r32;
        bf16x8 qr[4];
#pragma unroll
        for (int d0 = 0; d0 < 4; ++d0) qr[d0] = qn[d0];
        f32x16 o[2];
#pragma unroll
        for (int r = 0; r < 16; ++r) { o[0][r] = 0.f; o[1][r] = 0.f; }
        float m = sk, l = hi == 0 ? 1.f : 0.f;
        f32x16 negm;
#pragma unroll
        for (int r = 0; r < 16; ++r) negm[r] = -sk;
#pragma unroll 1
        for (int t = 0; t < 4; ++t) att_step<0, true>(F.lds + W_CTX + t * 16384, qr, o, m, l, wsf, r32, hi, lane, negm, dummy, dummy, nullptr, 0);
        const int jlo = max(qb - 2, 0), jhi = min(qb + 2, 31);
#pragma unroll 1
        for (int jt = jlo; jt <= jhi; ++jt) {
            const LAS unsigned char* img = F.lds + W_RING + (jt % 5) * 16384;
            if (jt == qb - 2 || jt == qb + 2) att_step<2, true>(img, qr, o, m, l, wsf, r32, hi, lane, negm, dummy, dummy, nullptr, qpos - jt * 64);
            else att_step<0, true>(img, qr, o, m, l, wsf, r32, hi, lane, negm, dummy, dummy, nullptr, 0);
            if (jt == jlo && i < 7) {
                __syncthreads();
                if (qb + 3 <= 31) stage_dma<1>(QKV, 1536, b * 2048 + (qb + 3) * 64, kcol, vcol, F.lds + W_RING + ((qb + 3) % 5) * 16384, lane, wave);
            }
        }
        if (i < 7) {
#pragma unroll
            for (int d0 = 0; d0 < 4; ++d0) qn[d0] = *(const bf16x8*)(QKV + (size_t)(qrow0 + 64 + r32) * 1536 + hq * 64 + d0 * 16 + hi * 8);
        }
        { const float lt = l + __shfl_xor(l, 32); wsf[r32] = __builtin_amdgcn_rcpf(lt);
#pragma unroll
          for (int g = 0; g < 4; ++g) {
#pragma unroll
              for (int rr = 0; rr < 4; ++rr) { const int r = 4 * g + rr; const float rl = wsf[crow(r, hi)]; const int lrow = rr + 4 * hi;
                  stg[lrow * 64 + r32] = (bf16)pk2(o[0][r] * rl, 0.f); stg[lrow * 64 + 32 + r32] = (bf16)pk2(o[1][r] * rl, 0.f); }
              const v4u v = *(const LAS v4u*)(stg + (lane >> 3) * 64 + (lane & 7) * 8);
              *(v4u*)(CAT + (size_t)(qrow0 + 8 * g + (lane >> 3)) * 1024 + hq * 64 + (lane & 7) * 8) = v; } }
        if (i < 7) ATT_DRAIN_BAR();
    }
}
}

__device__ __forceinline__ void conv_decode(int chunk, int& row_base, int& t0, int& L) {
    if (chunk < 1024) { row_base = chunk * 32; t0 = row_base & 2047; L = 2048; } else { const int cc = chunk - 1024; row_base = NL + cc * 32; t0 = (cc * 32) & 255; L = 256; }
}
__device__ __forceinline__ void conv_load(const bf16* P, int chunk, int tid, v4u (&pre)[8]) {
    int row_base, t0, L; conv_decode(chunk, row_base, t0, L);
    const int seq_base = row_base - t0;
#pragma unroll
    for (int it = 0; it < 8; ++it) { const int item = tid + NTHR * it, i = item >> 6, cg = item & 63, tt = t0 - 15 + i;
        v4u hw = {0u, 0u, 0u, 0u};
        if (item < 62 * 64 && tt >= 0 && tt < L) hw = *(const v4u*)(P + (size_t)(seq_base + tt) * 2560 + cg * 8);
        pre[it] = hw; }
}
typedef float cf2_t __attribute__((ext_vector_type(2)));
__device__ __forceinline__ void conv_chunk(Frame& F, const bf16* P, const cf2_t (&we)[15], const cf2_t (&wo)[15], float w0, float w30, float cb, const float* lng, const float* lnb, bf16* CAT, int chunk, int nxt, v4u (&pre)[8]) {
    int row_base, t0, L; conv_decode(chunk, row_base, t0, L);
    const int c = F.tid;
    LAS bf16* HG = (LAS bf16*)(F.lds + 65536);
#pragma unroll
    for (int it = 0; it < 8; ++it) { const int item = F.tid + NTHR * it; if (item < 62 * 64) *(LAS v4u*)(HG + (item >> 6) * 512 + (item & 63) * 8) = pre[it]; }
    asm volatile("s_waitcnt lgkmcnt(0)\n\ts_barrier" ::: "memory");
    if (nxt >= 0) conv_load(P, nxt, F.tid, pre);
    typedef float f2_t __attribute__((ext_vector_type(2)));
    f2_t E[31];
#pragma unroll
    for (int jj = 0; jj < 31; ++jj) { E[jj].x = bf2f(HG[(2 * jj) * 512 + c]); E[jj].y = bf2f(HG[(2 * jj + 1) * 512 + c]); }
    LAS float* CO = (LAS float*)F.lds;
#pragma unroll
    for (int tp = 0; tp < 16; ++tp) {
        f2_t a0 = {cb, 0.f}, a1 = {cb, 0.f};
#pragma unroll
        for (int q = 0; q < 15; ++q) { a0 = E[tp + q] * we[q] + a0; a1 = E[tp + 1 + q] * wo[q] + a1; }
        CO[(2 * tp) * 512 + c] = (a0.x + a0.y) + E[tp + 15].x * w30;
        CO[(2 * tp + 1) * 512 + c] = (a1.x + a1.y) + E[tp].y * w0; }
    asm volatile("s_waitcnt lgkmcnt(0)\n\ts_barrier" ::: "memory");
#pragma unroll
    for (int q = 0; q < 4; ++q) { const int tk = F.wave * 4 + q;
        const f32x4 x0 = *(const LAS f32x4*)(CO + tk * 512 + 8 * F.lane), x1 = *(const LAS f32x4*)(CO + tk * 512 + 8 * F.lane + 4);
        const float mean = wave_sum((x0[0] + x0[1]) + (x0[2] + x0[3]) + (x1[0] + x1[1]) + (x1[2] + x1[3])) * (1.f / 512.f);
        const f32x4 d0 = x0 - mean, d1 = x1 - mean;
        const float var = wave_sum((d0[0] * d0[0] + d0[1] * d0[1]) + (d0[2] * d0[2] + d0[3] * d0[3]) + (d1[0] * d1[0] + d1[1] * d1[1]) + (d1[2] * d1[2] + d1[3] * d1[3])) * (1.f / 512.f);
        const float rstd = rsqrtf(var + LN_EPS);
        const f32x4 y0 = d0 * rstd * *(const f32x4*)(lng + 8 * F.lane) + *(const f32x4*)(lnb + 8 * F.lane), y1 = d1 * rstd * *(const f32x4*)(lng + 8 * F.lane + 4) + *(const f32x4*)(lnb + 8 * F.lane + 4);
        f32x4 s0, s1;
#pragma unroll
        for (int e = 0; e < 4; ++e) { s0[e] = y0[e] * __builtin_amdgcn_rcpf(1.f + __expf(-y0[e])); s1[e] = y1[e] * __builtin_amdgcn_rcpf(1.f + __expf(-y1[e])); }
        v4u ov; ov.x = pk2(s0[0], s0[1]); ov.y = pk2(s0[2], s0[3]); ov.z = pk2(s1[0], s1[1]); ov.w = pk2(s1[2], s1[3]);
        *(v4u*)(CAT + (size_t)(row_base + tk) * 1024 + 8 * F.lane) = ov; }
}
__device__ __forceinline__ void phase_mix0(Frame& F, const Args& A, int only) {
    unsigned char* ws = A.ws;
    const bf16* P = (const bf16*)(ws + WS_PROJ); bf16* CAT = (bf16*)(ws + WS_CAT);
    if (only == 0 || only == 1) {   float w[31];
#pragma unroll
        for (int k = 0; k < 31; ++k) w[k] = A.in[10][k * 512 + F.tid];
        cf2_t we[15], wo[15];
#pragma unroll
        for (int q = 0; q < 15; ++q) { we[q].x = w[2 * q]; we[q].y = w[2 * q + 1]; wo[q].x = w[2 * q + 1]; wo[q].y = w[2 * q + 2]; }
        const float cb = A.in[11][F.tid];
        v4u pre[8]; const int ch0 = (F.vcu + 128) % F.G;
        __syncthreads();
        if (ch0 < 1152) conv_load(P, ch0, F.tid, pre);
        for (int ch = ch0; ch < 1152; ch += F.G) conv_chunk(F, P, we, wo, w[0], w[30], cb, A.in[12], A.in[13], CAT, ch, ch + F.G < 1152 ? ch + F.G : -1, pre);
        __syncthreads();
    }
    if (only == 0 || only == 2 || only == 4) for (int u = F.vcu; u < 1024; u += F.G) att::na_pair_unit(F, P, A.in[14], CAT, u >> 6, u & 15, (u >> 4) & 3, only == 4);
    if (only == 0 || only == 3) for (int u = F.vcu; u < 128; u += F.G) att::na_unit<false>(F, P, A.in[14], CAT, u >> 3, u & 3, (u >> 2) & 1);
}
__device__ __forceinline__ void phase_attn1(Frame& F, const Args& A, int abl) {
    unsigned char* ws = A.ws;
    const bf16* QKV = (const bf16*)(ws + WS_PROJ); bf16* CAT = (bf16*)(ws + WS_CAT);
    for (int u = F.vcu; u < 256; u += F.G) att::win_super(F, QKV, A.in[18], CAT, u >> 4, (u >> 2) & 3, u & 3);
}

#ifndef REP_MASK
#define REP_MASK 0
#endif
#define REP(k) ((REP_MASK >> (k)) & 1)
#define PH(k, ...) if (IN(k)) { __VA_ARGS__ SEAM(k); }
#define MOE_LAYER(L_, P5, HINL, HINC) \
    PH(P5, phase_ln1<L_>(F, args, dry);) \
    PH(P5 + 2, moe_tiles<L_>(F); \
        pg8::Gemm g{(const bf16*)(ws + WS_ACT), (const bf16*)(ws + WS_WGU) + (size_t)L_ * 16 * 512 * 1024, 0, 0, 1024}; \
        pg8::OrderMoE<2> S; S.init((const LAS int*)(F.lds + MOE_LDS), (const int*)(ws + WS_LIST), F.G, (int)blockIdx.x); \
        pg8::EpiGLU E{(bf16*)(ws + WS_CAT), (const float*)(ws + WS_LISTW), (const LAS int*)(F.lds + MOE_LDS)}; \
        pg8::gemm_phase<pg8::EpiGLU, pg8::OrderMoE<2>, true, true, true>(F.lds, g, S, E); \
        if (L_ == 0) tail_items(F, args, ((const LAS int*)(F.lds + MOE_LDS))[16] * 2, PI_L0W, PI_EXP0);) \
    PH(P5 + 3, moe_tiles<L_>(F); int kdn = 256; asm volatile("" : "+s"(kdn)); \
        pg8::Gemm g{(const bf16*)(ws + WS_CAT), (const bf16*)(ws + WS_WD) + (size_t)L_ * 16 * 1024 * 256, 0, 0, kdn}; \
        pg8::OrderMoE<4> S; S.init((const LAS int*)(F.lds + MOE_LDS), (const int*)(ws + WS_LIST), F.G, (int)blockIdx.x); \
        pg8::EpiScatter E{(bf16*)(ws + WS_PROJ), (const int*)(ws + WS_LIST), (const LAS int*)(F.lds + MOE_LDS), NT, 0}; \
        pg8::gemm_phase<pg8::EpiScatter, pg8::OrderMoE<4>, true, true>(F.lds, g, S, E);) \
    PH(P5 + 4, phase_ln2<L_>(F, args, dry);)

__global__ void __launch_bounds__(NTHR, 2) mk_fwd(Args args) {
    extern __shared__ __attribute__((aligned(16))) unsigned char lds[];
    Frame F;
    F.lds = (LAS unsigned char*)lds;
    F.MISC = (volatile LAS unsigned*)(F.lds + MISC_OFF);
    F.tid = threadIdx.x; F.lane = F.tid & 63; F.wave = __builtin_amdgcn_readfirstlane(F.tid >> 6);
    F.G = gridDim.x; { const int bx = blockIdx.x; F.vcu = (F.G % 8 == 0) ? (bx % 8) * (F.G / 8) + bx / 8 : bx; }
    unsigned char* ws = args.ws;
    F.ctl = (gu32*)(ws + WS_CTL);
    for (int u = F.tid; u < (LDS_BYTES - LDSCTL_OFF) / 4; u += NTHR) ((LAS unsigned*)(F.lds + LDSCTL_OFF))[u] = 0u;
    __syncthreads();
    XcdBarrier bar = xcd_barrier_post((unsigned*)(F.ctl + CW_BAR) + args.li * XCD_BAR_WORDS, F.MISC + 8);
    const int lo = args.ph_lo, hi = args.ph_hi;
#define IN(k) (lo <= (k) && (k) < hi)
#define SEAM(k) do { if (IN(k) && (k) + 1 < hi) xcd_barrier(bar); } while (0)
    float* MOD = (float*)(ws + WS_MOD);
    bf16* ACT = (bf16*)(ws + WS_ACT); bf16* PROJ = (bf16*)(ws + WS_PROJ); bf16* CAT = (bf16*)(ws + WS_CAT);
    constexpr bool dry = false;

    PH(0, phase_mods(F, args.in[1], args.in[3], args.in[4], args.in[5], MOD, (float*)(ws + WS_ROPEC), (float*)(ws + WS_ROPES));)
    PH(1, phase_prep(F, args);)
    PH(2,
        pg8::Gemm g{ACT, (const bf16*)(ws + WS_WIN0), NT, 2560, 1024}; pg8::StaticOrder S; S.init(NT, 2560, F.G, (int)blockIdx.x);
        pg8::EpiIn0 E{PROJ, (const float*)(ws + WS_BIN0P), att::C2, 0};
        pg8::gemm_phase<pg8::EpiIn0, pg8::StaticOrder, true, true>(F.lds, g, S, E);)
    PH(3, phase_mix0(F, args, 0);)
    PH(4,
        pg8::Gemm g{CAT, (const bf16*)(ws + WS_WOUT0), NT, 1024, 1024}; pg8::StaticOrder S; S.init(NT, 1024, F.G, (int)blockIdx.x);
        pg8::EpiBias E{PROJ, 1024, args.in[16], 0, 0, 1.0f, 0};
        pg8::gemm_phase<pg8::EpiBias, pg8::StaticOrder, true, true>(F.lds, g, S, E);
        tail_items(F, args, (NT / 256) * 4, PI_EXP0, PI_EXP1);)
    MOE_LAYER(0, 5, args.in[0], args.in[2])
    PH(10,
        pg8::Gemm g{ACT, (const bf16*)(ws + WS_WIN1), NT, 1536, 1024}; pg8::OrderL1 S; S.init(F.G, (int)blockIdx.x);
        LAS float* RT = (LAS float*)(F.lds + 131072);
        for (int idx = F.tid; idx < 1536; idx += NTHR) { const int p = idx >> 4, i = idx & 15, src = p < 32 ? p * 2048 + i : (p - 32) * 32 + 16 + i;
            RT[idx] = ((const float*)(ws + WS_ROPEC))[src]; RT[1536 + idx] = ((const float*)(ws + WS_ROPES))[src]; }
        __syncthreads();
        pg8::EpiRope E{PROJ, RT};
        pg8::gemm_phase<pg8::EpiRope, pg8::OrderL1, true, true>(F.lds, g, S, E);
        tail_items(F, args, 800, PI_EXP1, PI_ALL);)
    PH(11, phase_attn1(F, args, 0);)
    PH(12,
        pg8::Gemm g{CAT, (const bf16*)(ws + WS_WOUT1), NL, 1024, 1024}; pg8::StaticOrder S; S.init(NL, 1024, F.G, (int)blockIdx.x);
        pg8::EpiBias E{PROJ, 1024, nullptr, 0, 0, 1.0f, 0};
        pg8::gemm_phase<pg8::EpiBias, pg8::StaticOrder, true, true>(F.lds, g, S, E);)
    MOE_LAYER(1, 13, HL, HC)
#undef IN
#undef SEAM
}

static int g_grid = 0;
static void launch_mk(const Args& base, int lo, int hi, int li, hipStream_t stream, int only = 0) {
    Args a = base; a.ph_lo = lo; a.ph_hi = hi; a.li = li; a.pad = (li > 0 ? 1 : 0) | (only << 1);
    hipLaunchKernelGGL(mk_fwd, dim3(g_grid), dim3(NTHR), LDS_BYTES, stream, a);
}
extern "C" void kernel_launch(void* const* d_in, const int* in_sizes, int n_in, void* d_out, int out_size, void* d_ws, size_t ws_size, hipStream_t stream) {
    if (ws_size < WS_END || n_in != 25) { fprintf(stderr, "kernel_launch: unexpected ws_size %zu / n_in %d\n", ws_size, n_in); return; }
    if (g_grid == 0) {
        int dev = 0, cus = 0;
        if (hipGetDevice(&dev) != hipSuccess || hipDeviceGetAttribute(&cus, hipDeviceAttributeMultiprocessorCount, dev) != hipSuccess) { g_grid = -1; return; }
        if (hipFuncSetAttribute((const void*)mk_fwd, hipFuncAttributeMaxDynamicSharedMemorySize, LDS_BYTES) != hipSuccess) { g_grid = -1; return; }
        g_grid = cus;
    }
    if (g_grid < 0) return;
    const float* x = (const float*)d_in[0]; const float* ctx = (const float*)d_in[2];
    const float* ln_g = (const float*)d_in[6]; const float* ln_b = (const float*)d_in[7];
    const float* conv_w = (const float*)d_in[10]; const float* conv_b = (const float*)d_in[11];
    const float* conv_ln_g = (const float*)d_in[12]; const float* conv_ln_b = (const float*)d_in[13]; const float* na_rpb = (const float*)d_in[14];
    const float* gqa_sink = (const float*)d_in[18]; const float* router_g = (const float*)d_in[20]; const float* router_e = (const float*)d_in[21];
    const float* wg = (const float*)d_in[22]; const float* wu = (const float*)d_in[23]; const float* wd = (const float*)d_in[24];
    unsigned char* ws = (unsigned char*)d_ws;
    float* MOD = (float*)(ws + WS_MOD); int* tok_e = (int*)(ws + WS_TOKE); float* tok_w = (float*)(ws + WS_TOKW);
    float* HC = (float*)(ws + WS_HC); float* HL = (float*)d_out;
    bf16* ACT = (bf16*)(ws + WS_ACT); bf16* PROJ = (bf16*)(ws + WS_PROJ); bf16* CAT = (bf16*)(ws + WS_CAT);
    (void)hipMemsetAsync(ws + WS_CTL, 0, CTL_ZERO_BYTES, stream);
    Args base{};
    for (int i = 0; i < 25; ++i) base.in[i] = (const float*)d_in[i];
    base.out = (float*)d_out; base.ws = ws;

    launch_mk(base, 0, 18, 0, stream);
}
```

```cpp
#include <hip/hip_runtime.h>
#include <cstdint>
#include <cstdio>

typedef unsigned short bf16;
__device__ __forceinline__ float bf2f(bf16 v) { return __uint_as_float(((unsigned)v) << 16); }
__device__ __forceinline__ bf16 f2bf(float f) { unsigned u = __float_as_uint(f); return (bf16)((u + 0x7fffu + ((u >> 16) & 1u)) >> 16); }

constexpr int D = 1024, NB = 16, SEQ = 2048, CL = 256;
constexpr int NL = NB * SEQ, NC = NB * CL, NT = NL + NC;
constexpr float ALPHA = 1.41421356237309515f;
constexpr float LN_EPS = 1e-5f;
constexpr float NEG_INF = -1e30f;

constexpr size_t MiB = 1u << 20;
constexpr size_t WS_CTL = 0, WS_MOD = 1 * MiB, WS_ROPE = 2 * MiB, WS_TOKE = 3 * MiB, WS_TOKW = 3 * MiB + 512 * 1024;
constexpr size_t WS_HC = 72 * MiB, WS_ACT = 88 * MiB, WS_PROJ = 160 * MiB, WS_CAT = 340 * MiB, WS_END = 494 * MiB;

__device__ __forceinline__ int mod_row(int r) { return r < NL ? (r >> 11) : 16; }
__device__ __forceinline__ float silu_f(float x) { return x / (1.f + __expf(-x)); }


namespace pg8 {
#define PG8_LAS __attribute__((address_space(3)))
typedef unsigned short bf16_t;
typedef short bf16x8 __attribute__((ext_vector_type(8)));
typedef float f32x4 __attribute__((ext_vector_type(4)));
typedef unsigned u32x4 __attribute__((ext_vector_type(4)));
constexpr int BM = 256, BK = 64, HALF = 128, HTB = HALF * BK * 2  , STAGE_BYTES = 8 * HTB, NXCD = 8, WGM = 8;

__host__ __device__ __forceinline__ int lds_byte(int r, int c) { const int st = (r >> 4) * 2 + (c >> 5), rr = r & 15, cc = c & 31, ob = rr * 64 + cc * 2; return st * 1024 + (ob ^ (((ob >> 9) & 1) << 5)); }
__host__ __device__ __forceinline__ void stage_rc(int b, int& R, int& C) { const int st = b / 1024, sb = b % 1024, swz = sb ^ (((sb >> 9) & 1) << 5); R = (st >> 1) * 16 + swz / 64; C = (st & 1) * 32 + (swz % 64) / 2; }
__host__ __device__ __forceinline__ int perm32(int rho) { const int n = rho >> 4, i = rho & 15; return 8 * (i >> 2) + 4 * n + (i & 3); }

struct Unit { int pm, pn; };
struct Gemm { const bf16_t* A; const bf16_t* Bt; int M, N, K; };

struct StaticOrder {
    int nM, nN, nwg, G, c;
    __host__ __device__ void init(int M, int N, int G_, int c_) { nM = M / BM; nN = N / BM; nwg = nM * nN; G = G_; c = c_; }
    __host__ __device__ bool next(int i, Unit& u) const {
        const long L = (long)i * G + c; if (L >= nwg) return false;
        int wgid = (int)L; { const int q = nwg / NXCD, r = nwg % NXCD, xcd = wgid % NXCD, off = wgid / NXCD; wgid = (xcd < r ? xcd * (q + 1) : r * (q + 1) + (xcd - r) * q) + off; }
        const int nig = WGM * nN, gid = wgid / nig, fm = gid * WGM, gsz = (nM - fm) < WGM ? (nM - fm) : WGM;
        u.pm = fm + ((wgid % nig) % gsz); u.pn = (wgid % nig) / gsz; return true;
    }
    __device__ __forceinline__ void a_ready(const Unit&) const {}
    __device__ __forceinline__ void done(const Unit&) const {}
};

__device__ __forceinline__ unsigned cvt_pk_bf16(float lo, float hi) { unsigned r; asm volatile("v_cvt_pk_bf16_f32 %0, %1, %2" : "=v"(r) : "v"(lo), "v"(hi)); return r; }
typedef unsigned u32x2 __attribute__((ext_vector_type(2)));
constexpr int EP_NL = 32768;
struct EpiBias {
    static constexpr bool PERM = true, AFTER_DRAIN = false;
    bf16_t* O; int ldc; const float* bias; int sc_lo, sc_hi; float sc; int nostore;
    __device__ __forceinline__ void operator()(const f32x4 (&acc)[2][2][4][2], const Unit& u, int wr, int wc, int fr, int fq) const {
        const int row0 = u.pm * BM + wr * 64 + fr; const int col0 = u.pn * BM + wc * 32 + 8 * fq;
        f32x4 bv[2][2];
#pragma unroll
        for (int bj = 0; bj < 2; ++bj)
#pragma unroll
            for (int n = 0; n < 2; ++n) bv[bj][n] = bias ? *(const f32x4*)(bias + col0 + bj * HALF + 4 * n) : (f32x4){0.f, 0.f, 0.f, 0.f};
#pragma unroll
        for (int ai = 0; ai < 2; ++ai)
#pragma unroll
            for (int m = 0; m < 4; ++m) { bf16_t* rowp = O + (size_t)(row0 + ai * HALF + m * 16) * ldc + col0;
#pragma unroll
                for (int bj = 0; bj < 2; ++bj) { const int cg = col0 + bj * HALF; const float sf = (cg >= sc_lo && cg < sc_hi) ? sc : 1.0f;
                    const f32x4 v0 = (acc[ai][bj][m][0] + bv[bj][0]) * sf, v1 = (acc[ai][bj][m][1] + bv[bj][1]) * sf;
                    u32x4 w; w.x = cvt_pk_bf16(v0[0], v0[1]); w.y = cvt_pk_bf16(v0[2], v0[3]); w.z = cvt_pk_bf16(v1[0], v1[1]); w.w = cvt_pk_bf16(v1[2], v1[3]);
                    if (!nostore) *(u32x4*)(rowp + bj * HALF) = w; else asm volatile("" :: "v"(w)); } }
    }
};
struct EpiIn0 {
    static constexpr bool PERM = true, AFTER_DRAIN = false;
    bf16_t* O; const float* bias; float qs; int nostore;
    __device__ __forceinline__ void operator()(const f32x4 (&acc)[2][2][4][2], const Unit& u, int wr, int wc, int fr, int fq) const {
        const int row0 = u.pm * BM + wr * 64 + fr; const int col0 = u.pn * BM + wc * 32 + 8 * fq;
        f32x4 bv[2][2];
#pragma unroll
        for (int bj = 0; bj < 2; ++bj)
#pragma unroll
            for (int n = 0; n < 2; ++n) bv[bj][n] = *(const f32x4*)(bias + col0 + bj * HALF + 4 * n);
#pragma unroll
        for (int ai = 0; ai < 2; ++ai)
#pragma unroll
            for (int m = 0; m < 4; ++m) { bf16_t* rowp = O + (size_t)(row0 + ai * HALF + m * 16) * 2560;
#pragma unroll
                for (int bj = 0; bj < 2; ++bj) { const int cg = col0 + bj * HALF;
                    f32x4 v0 = acc[ai][bj][m][0] + bv[bj][0], v1 = acc[ai][bj][m][1] + bv[bj][1];
                    if (cg < 1024) {
                        f32x4 h;
#pragma unroll
                        for (int q = 0; q < 4; ++q) h[q] = v0[q] * __builtin_amdgcn_rcpf(1.0f + __expf(-v1[q]));
                        u32x2 w; w.x = cvt_pk_bf16(h[0], h[1]); w.y = cvt_pk_bf16(h[2], h[3]);
                        if (!nostore) *(u32x2*)(rowp + (cg >> 1)) = w; else asm volatile("" :: "v"(w));
                    } else {
                        const float sf = cg < 1536 ? qs : 1.0f; v0 = v0 * sf; v1 = v1 * sf;
                        u32x4 w; w.x = cvt_pk_bf16(v0[0], v0[1]); w.y = cvt_pk_bf16(v0[2], v0[3]); w.z = cvt_pk_bf16(v1[0], v1[1]); w.w = cvt_pk_bf16(v1[2], v1[3]);
                        if (!nostore) *(u32x4*)(rowp + cg) = w; else asm volatile("" :: "v"(w));
                    } } }
    }
};
struct EpiRope {
    static constexpr bool PERM = true, AFTER_DRAIN = false;
    bf16_t* O; const PG8_LAS float* rt;
    __device__ __forceinline__ void operator()(const f32x4 (&acc)[2][2][4][2], const Unit& u, int wr, int wc, int fr, int fq) const {
        const int row0 = u.pm * BM + wr * 64 + fr; const int c8b = u.pn * BM + wc * 32 + 8 * fq;
        const bool lat = (u.pm * BM) < EP_NL;
#pragma unroll
        for (int ai = 0; ai < 2; ++ai)
#pragma unroll
            for (int m = 0; m < 4; ++m) { const int row = row0 + ai * HALF + m * 16; const int t = row & 2047; bf16_t* rowp = O + (size_t)row * 1536;
#pragma unroll
                for (int bj = 0; bj < 2; ++bj) { const int c8 = c8b + bj * HALF; const f32x4 v0 = acc[ai][bj][m][0], v1 = acc[ai][bj][m][1];
                    if (c8 < 1280) {
                        const int head = c8 >> 6, pos = c8 & 63, a = pos >> 5, i0 = ((pos & 31) >> 3) * 4;
                        f32x4 o1 = v0, o2 = v1;
                        if (lat) { const int e = (a == 0 ? (t >> 6) : 32 + (t & 63)) * 16 + i0;
                            const f32x4 cs = *(const PG8_LAS f32x4*)(rt + e), sn = *(const PG8_LAS f32x4*)(rt + 1536 + e);
                            o1 = v0 * cs - v1 * sn; o2 = v1 * cs + v0 * sn; }
                        if (c8 < 1024) { o1 = o1 * 0.18033688011112042f; o2 = o2 * 0.18033688011112042f; }
                        u32x2 w1, w2; w1.x = cvt_pk_bf16(o1[0], o1[1]); w1.y = cvt_pk_bf16(o1[2], o1[3]); w2.x = cvt_pk_bf16(o2[0], o2[1]); w2.y = cvt_pk_bf16(o2[2], o2[3]);
                        bf16_t* p = rowp + head * 64 + a * 32 + i0;
                        *(u32x2*)p = w1; *(u32x2*)(p + 16) = w2;
                    } else {
                        u32x4 w; w.x = cvt_pk_bf16(v0[0], v0[1]); w.y = cvt_pk_bf16(v0[2], v0[3]); w.z = cvt_pk_bf16(v1[0], v1[1]); w.w = cvt_pk_bf16(v1[2], v1[3]);
                        *(u32x4*)(rowp + c8) = w;
                    } } }
    }
};
struct OrderL1 {
    StaticOrder so; int G, c, mode; unsigned* flag;
    __device__ void init(int G_, int c_, int mode_, unsigned* flag_) { so.init(EP_NL, 1536, G_, c_); G = G_; c = c_; mode = mode_; flag = flag_; }
    __device__ bool next(int i, Unit& u) const {
        if (mode == 0) return so.next(i, u);
        if (i > 0 || c >= 32) return false;
        u.pm = 128 + (c >> 1); u.pn = 4 + (c & 1); return true;
    }
    __device__ __forceinline__ void a_ready(const Unit& u) const {
        if (mode == 1) {
            if (threadIdx.x < 64) {
                unsigned sp = 0;
                while ((unsigned)__builtin_amdgcn_readfirstlane(__hip_atomic_load(flag + 64 * (u.pm - 128), __ATOMIC_RELAXED, __HIP_MEMORY_SCOPE_AGENT)) < 16u) { __builtin_amdgcn_s_sleep(2); if (++sp > (1u << 20)) break; }
                __builtin_amdgcn_fence(__ATOMIC_ACQUIRE, "agent");
                asm volatile("s_waitcnt vmcnt(0)" ::: "memory");
            }
            asm volatile("" ::: "memory"); __builtin_amdgcn_s_barrier(); asm volatile("" ::: "memory");
        }
    }
    __device__ __forceinline__ void done(const Unit&) const {}
};
constexpr int MOE_CAP = 73728;
__device__ __forceinline__ int xcd_remap(int wgid, int nwg) { const int q = nwg / NXCD, r = nwg % NXCD, xcd = wgid % NXCD, off = wgid / NXCD; return (xcd < r ? xcd * (q + 1) : r * (q + 1) + (xcd - r) * q) + off; }
template <int NPN> struct OrderMoE {
    const PG8_LAS int* ts; const int* list; int G, c, nwg;
    int lo, n, ns, nr, remap, sig, rt_dep; unsigned* flag; PG8_LAS unsigned* lcnt;
    __device__ void init(const PG8_LAS int* ts_, const int* list_, int G_, int c_) { ts = ts_; list = list_; G = G_; c = c_; nwg = __builtin_amdgcn_readfirstlane(ts_[16]) * NPN;
        lo = 0; n = nwg; ns = 0; nr = 0; remap = 1; sig = 0; rt_dep = 1 << 30; flag = nullptr; lcnt = nullptr; }
    __device__ __forceinline__ unsigned a_rowoff(const Unit& u, int row) const { const int e = u.pn / NPN, p = (u.pm - __builtin_amdgcn_readfirstlane(ts[e])) * 256 + row;
        const int slot = p < __builtin_amdgcn_readfirstlane(ts[32 + e]) ? list[(size_t)e * MOE_CAP + p] : 0; return (unsigned)(slot >> 1) * 2048u; }
    __device__ bool next(int i, Unit& u) const {
        const int r = i + (c < ns ? nr : 0);
        const long idx = r < nr ? (long)r * (G - ns) + (c - ns) : (long)nr * (G - ns) + (long)(r - nr) * G + c;
        if (idx >= n) return false;
        const int d1 = NPN == 4 ? (rt_dep < (1 << 28) ? min(rt_dep * 4, n) : n) : n;
        const int wgid = lo + (remap ? (idx < d1 ? xcd_remap((int)idx, d1) : (int)idx) : (int)idx), rt = wgid / NPN, pc = wgid % NPN;
        int e = 0;
#pragma unroll
        for (int j = 1; j < 16; ++j) e += (rt >= __builtin_amdgcn_readfirstlane(ts[j])) ? 1 : 0;
        u.pm = rt; u.pn = e * NPN + pc; return true;
    }
    __device__ __forceinline__ void a_ready(const Unit& u) const {
        if constexpr (NPN == 4) {
            if (u.pm >= rt_dep) {
                if (threadIdx.x < 64) {
                    unsigned sp = 0;
                    while ((unsigned)__builtin_amdgcn_readfirstlane(__hip_atomic_load(flag + 64 * u.pm, __ATOMIC_RELAXED, __HIP_MEMORY_SCOPE_AGENT)) < 2u) { __builtin_amdgcn_s_sleep(2); if (++sp > (1u << 20)) break; }
                    __builtin_amdgcn_fence(__ATOMIC_ACQUIRE, "agent");
                    asm volatile("s_waitcnt vmcnt(0)" ::: "memory");
                }
                asm volatile("" ::: "memory"); __builtin_amdgcn_s_barrier(); asm volatile("" ::: "memory");
            }
        }
    }
    __device__ __forceinline__ void done(const Unit& u) const {
        if constexpr (NPN == 2) {
            if (sig) {
                asm volatile("s_waitcnt vmcnt(0)" ::: "memory");
                if ((threadIdx.x & 63) == 0) {
                    const unsigned old = __hip_atomic_fetch_add(lcnt, 1u, __ATOMIC_RELAXED, __HIP_MEMORY_SCOPE_WORKGROUP);
                    if (old == 7u) {
                        __hip_atomic_store(lcnt, 0u, __ATOMIC_RELAXED, __HIP_MEMORY_SCOPE_WORKGROUP);
                        __hip_atomic_fetch_add(flag + 64 * u.pm, 1u, __ATOMIC_RELAXED, __HIP_MEMORY_SCOPE_AGENT);
                    } } } }
    }
};
struct EpiGLU {
    static constexpr bool PERM = true, AFTER_DRAIN = false;
    bf16_t* H; const float* listw; const PG8_LAS int* ts; int wt;
    __device__ __forceinline__ void operator()(const f32x4 (&acc)[2][2][4][2], const Unit& u, int wr, int wc, int fr, int fq) const {
        const int row0 = u.pm * BM + wr * 64 + fr; const int hc0 = (u.pn & 1) * 128 + wc * 16 + 4 * fq;
        const int e = u.pn >> 1, p0 = (u.pm - ts[e]) * 256 + wr * 64 + fr, cnt = ts[32 + e]; const float* lw = listw + (size_t)e * MOE_CAP;
#pragma unroll
        for (int ai = 0; ai < 2; ++ai)
#pragma unroll
            for (int m = 0; m < 4; ++m) { const int row = row0 + ai * HALF + m * 16; const int p = p0 + ai * HALF + m * 16; const float w = p < cnt ? lw[p] : 0.f; bf16_t* rowp = H + (size_t)row * 256 + hc0;
#pragma unroll
                for (int bj = 0; bj < 2; ++bj) { const f32x4 g = acc[ai][bj][m][0], uu = acc[ai][bj][m][1]; f32x4 h;
#pragma unroll
                    for (int q = 0; q < 4; ++q) h[q] = g[q] * __builtin_amdgcn_rcpf(1.0f + __expf(-g[q])) * uu[q] * w;
                    u32x2 o; o.x = cvt_pk_bf16(h[0], h[1]); o.y = cvt_pk_bf16(h[2], h[3]);
                    if (wt) __hip_atomic_store((unsigned long long*)(rowp + bj * 64), (unsigned long long)o.x | ((unsigned long long)o.y << 32), __ATOMIC_RELAXED, __HIP_MEMORY_SCOPE_AGENT);
                    else *(u32x2*)(rowp + bj * 64) = o; } }
    }
};
struct EpiScatter {
    static constexpr bool PERM = true, AFTER_DRAIN = false;
    bf16_t* YP; const int* list; const PG8_LAS int* ts; int ntok; int nostore;
    __device__ __forceinline__ void operator()(const f32x4 (&acc)[2][2][4][2], const Unit& u, int wr, int wc, int fr, int fq) const {
        const unsigned col0 = (unsigned)((u.pn & 3) * BM + wc * 32 + 8 * fq);
        const int e = u.pn >> 2, p0 = (u.pm - ts[e]) * 256 + wr * 64 + fr, cnt = ts[32 + e]; const int* ls = list + (size_t)e * MOE_CAP;
        int sl[8];
#pragma unroll
        for (int q = 0; q < 8; ++q) { const int p = p0 + (q >> 2) * HALF + (q & 3) * 16; sl[q] = p < cnt ? ls[p] : -1; }
        asm volatile("" ::: "memory");
#pragma unroll
        for (int ai = 0; ai < 2; ++ai)
#pragma unroll
            for (int m = 0; m < 4; ++m) { const int s = sl[ai * 4 + m];
                if (s >= 0) { const unsigned off = ((unsigned)(s & 1) * (unsigned)ntok + (unsigned)(s >> 1)) * 1024u + col0;
#pragma unroll
                    for (int bj = 0; bj < 2; ++bj) { const f32x4 v0 = acc[ai][bj][m][0], v1 = acc[ai][bj][m][1];
                        u32x4 w; w.x = cvt_pk_bf16(v0[0], v0[1]); w.y = cvt_pk_bf16(v0[2], v0[3]); w.z = cvt_pk_bf16(v1[0], v1[1]); w.w = cvt_pk_bf16(v1[2], v1[3]);
                        if (!nostore) *(u32x4*)(YP + off + bj * HALF) = w; else asm volatile("" :: "v"(w)); } }
                asm volatile("" ::: "memory"); }
    }
};
template <class Epi, class Sched, bool ALIGN_EPI = false, bool SP2 = false, bool GATHER = false>
__device__ __forceinline__ void gemm_phase(PG8_LAS unsigned char* lds, const Gemm g, const Sched& S, const Epi& E) {
    int tid_ = threadIdx.x; asm volatile("" : "+v"(tid_));
    const int tid = tid_, wid = __builtin_amdgcn_readfirstlane(tid >> 6), lane = tid & 63, wr = wid >> 2, wc = wid & 3, fr = lane & 15, fq = lane >> 4;
    const int K = g.K, nt = K / BK;
    unsigned voffA[2], voffB[2];
#pragma unroll
    for (int i = 0; i < 2; ++i) { int R, C; stage_rc(tid * 16 + i * 8192, R, C); const int Rb = Epi::PERM ? ((R & ~31) + perm32(R & 31)) : R;
        voffA[i] = (unsigned)(R * K + C) * 2u; voffB[i] = (unsigned)(Rb * K + C) * 2u; }
    const size_t kstep = (size_t)(BK * 2);
    const size_t hstep = (size_t)HALF * K * 2;
    const size_t tstep = 2 * hstep;
    const unsigned ldsw = (unsigned)wid * 1024u;
    const int aoff = lds_byte(wr * 64 + fr, fq * 8), boff = lds_byte(wc * 32 + fr, fq * 8);
#define PG8_SA(b, h) (((b) * 2 + (h)) * HTB)
#define PG8_SB(b, h) ((4 + (b) * 2 + (h)) * HTB)
#define PG8_STAGE_A(bufoff, gbase, h, nx) do { if constexpr (GATHER) { _Pragma("unroll") for (int _i = 0; _i < 2; ++_i) \
        __builtin_amdgcn_global_load_lds((const unsigned*)((const char*)(gbase) + ((nx) ? gn[h][_i] : gc[h][_i])), (PG8_LAS unsigned*)(lds + (bufoff) + ldsw + _i * 8192), 16, 0, 0); } \
        else { PG8_STAGE(bufoff, (gbase) + (h) * hstep, voffA); } } while (0)
#define PG8_STAGE(bufoff, gbase, voff) do { _Pragma("unroll") for (int _i = 0; _i < 2; ++_i) \
        __builtin_amdgcn_global_load_lds((const unsigned*)((const char*)(gbase) + (voff)[_i]), (PG8_LAS unsigned*)(lds + (bufoff) + ldsw + _i * 8192), 16, 0, 0); } while (0)
#define PG8_LDA(dst, b, h) do { _Pragma("unroll") for (int m = 0; m < 4; ++m) _Pragma("unroll") for (int k = 0; k < 2; ++k) dst[m][k] = *(const PG8_LAS bf16x8*)(lds + PG8_SA(b, h) + aoff + m * 2048 + k * 1024); } while (0)
#define PG8_LDB(dst, b, h) do { _Pragma("unroll") for (int n = 0; n < 2; ++n) _Pragma("unroll") for (int k = 0; k < 2; ++k) dst[n][k] = *(const PG8_LAS bf16x8*)(lds + PG8_SB(b, h) + boff + n * 2048 + k * 1024); } while (0)
#define PG8_MMA(ai, bj, At, Bt) do { __builtin_amdgcn_s_setprio(1); _Pragma("unroll") for (int m = 0; m < 4; ++m) _Pragma("unroll") for (int n = 0; n < 2; ++n) _Pragma("unroll") for (int k = 0; k < 2; ++k) \
        acc[ai][bj][m][n] = __builtin_amdgcn_mfma_f32_16x16x32_bf16(Bt[n][k], At[m][k], acc[ai][bj][m][n], 0, 0, 0); __builtin_amdgcn_s_setprio(0); } while (0)
#define PG8_WAIT_V(n) asm volatile("s_waitcnt vmcnt(" #n ")" ::: "memory")
#define PG8_WAIT_L(n) asm volatile("s_waitcnt lgkmcnt(" #n ")" ::: "memory")
#define PG8_BAR __builtin_amdgcn_s_barrier()
#define PG8_SCHED __builtin_amdgcn_sched_barrier(0)
    Unit cur, nxt; int ui = 0;
    if (!S.next(0, cur)) return;
    f32x4 acc[2][2][4][2];
#pragma unroll
    for (int a = 0; a < 2; ++a)
#pragma unroll
        for (int b = 0; b < 2; ++b)
#pragma unroll
            for (int m = 0; m < 4; ++m)
#pragma unroll
                for (int n = 0; n < 2; ++n) acc[a][b][m][n] = (f32x4){0.f, 0.f, 0.f, 0.f};
    bf16x8 At[4][2], B0[2][2], B1[2][2];
    const char* cA = (const char*)g.A + (GATHER ? (size_t)0 : (size_t)cur.pm * tstep); const char* cB = (const char*)g.Bt + (size_t)cur.pn * tstep;
    unsigned gc[2][2], gn[2][2];
    if constexpr (GATHER) {
#pragma unroll
        for (int h = 0; h < 2; ++h)
#pragma unroll
            for (int i = 0; i < 2; ++i) { int R, C; stage_rc(tid * 16 + i * 8192, R, C); gc[h][i] = S.a_rowoff(cur, h * HALF + R) + (unsigned)C * 2u; gn[h][i] = gc[h][i]; } }
    S.a_ready(cur);
    if constexpr (SP2) {
        PG8_STAGE(PG8_SB(0, 0), cB, voffB); PG8_STAGE(PG8_SB(0, 1), cB + hstep, voffB); PG8_STAGE_A(PG8_SA(0, 0), cA, 0, false); PG8_STAGE_A(PG8_SA(0, 1), cA, 1, false);
        if (wr == 1) PG8_BAR;
        PG8_WAIT_V(2); PG8_BAR;
        PG8_STAGE(PG8_SB(1, 0), cB + kstep, voffB); PG8_STAGE_A(PG8_SA(1, 0), cA + kstep, 0, false); PG8_STAGE(PG8_SB(1, 1), cB + hstep + kstep, voffB);
        PG8_WAIT_V(6); PG8_BAR;
    } else {
        PG8_STAGE(PG8_SB(0, 0), cB, voffB); PG8_STAGE_A(PG8_SA(0, 0), cA, 0, false); PG8_STAGE(PG8_SB(0, 1), cB + hstep, voffB); PG8_STAGE_A(PG8_SA(0, 1), cA, 1, false);
        if (wr == 1) PG8_BAR;
        PG8_WAIT_V(4); PG8_BAR;
        PG8_STAGE(PG8_SB(1, 0), cB + kstep, voffB); PG8_STAGE_A(PG8_SA(1, 0), cA + kstep, 0, false); PG8_STAGE(PG8_SB(1, 1), cB + hstep + kstep, voffB);
        PG8_WAIT_V(6); PG8_BAR;
    }
    for (;;) {
        const bool has_next = S.next(ui + 1, nxt);
        if constexpr (GATHER) { if (has_next) {
#pragma unroll
            for (int h = 0; h < 2; ++h)
#pragma unroll
                for (int i = 0; i < 2; ++i) { int R, C; stage_rc(tid * 16 + i * 8192, R, C); gn[h][i] = S.a_rowoff(nxt, h * HALF + R) + (unsigned)C * 2u; } } }
        const char* nA = GATHER ? (const char*)g.A : (has_next ? (const char*)g.A + (size_t)nxt.pm * tstep : cA); const char* nB = has_next ? (const char*)g.Bt + (size_t)nxt.pn * tstep : cB;
        for (int t = 0; t < nt; t += 2) {
            const bool last = (t == nt - 2);
            const char* a1 = cA + (size_t)(t + 1) * kstep;
            const char* a2 = last ? nA : cA + (size_t)(t + 2) * kstep; const char* b2 = last ? nB : cB + (size_t)(t + 2) * kstep;
            const char* a3 = a2 + kstep; const char* b3 = b2 + kstep;
            if (last && has_next) S.a_ready(nxt);
            if constexpr (SP2) {
            PG8_LDB(B0, 0, 0); PG8_LDB(B1, 0, 1); PG8_SCHED; PG8_LDA(At, 0, 0); PG8_STAGE_A(PG8_SA(1, 1), a1, 1, false);
            PG8_WAIT_V(8); PG8_WAIT_L(0); PG8_BAR; PG8_MMA(0, 0, At, B0); PG8_MMA(0, 1, At, B1); PG8_BAR; PG8_SCHED;
            PG8_LDA(At, 0, 1); PG8_STAGE(PG8_SB(0, 0), b2, voffB); PG8_STAGE(PG8_SB(0, 1), b2 + hstep, voffB); PG8_STAGE_A(PG8_SA(0, 0), a2, 0, last);
            PG8_WAIT_V(8); PG8_WAIT_L(0); PG8_BAR; PG8_MMA(1, 0, At, B0); PG8_MMA(1, 1, At, B1); PG8_BAR; PG8_SCHED;
            PG8_LDB(B0, 1, 0); PG8_LDB(B1, 1, 1); PG8_SCHED; PG8_LDA(At, 1, 0); PG8_STAGE_A(PG8_SA(0, 1), a2, 1, last);
            PG8_WAIT_V(8); PG8_WAIT_L(0); PG8_BAR; PG8_MMA(0, 0, At, B0); PG8_MMA(0, 1, At, B1); PG8_BAR; PG8_SCHED;
            PG8_LDA(At, 1, 1); PG8_STAGE(PG8_SB(1, 0), b3, voffB); PG8_STAGE(PG8_SB(1, 1), b3 + hstep, voffB); PG8_STAGE_A(PG8_SA(1, 0), a3, 0, last);
            PG8_WAIT_V(8); PG8_WAIT_L(0); PG8_BAR; PG8_MMA(1, 0, At, B0); PG8_MMA(1, 1, At, B1); PG8_BAR; PG8_SCHED;
            } else {
            PG8_LDB(B0, 0, 0); PG8_SCHED; PG8_LDA(At, 0, 0); PG8_STAGE_A(PG8_SA(1, 1), a1, 1, false);
            PG8_WAIT_L(8); PG8_BAR; PG8_WAIT_L(0); PG8_MMA(0, 0, At, B0); PG8_BAR; PG8_SCHED;
            PG8_LDB(B1, 0, 1); PG8_STAGE(PG8_SB(0, 0), b2, voffB);
            PG8_BAR; PG8_WAIT_L(0); PG8_MMA(0, 1, At, B1); PG8_BAR;
            PG8_LDA(At, 0, 1); PG8_STAGE_A(PG8_SA(0, 0), a2, 0, last);
            PG8_BAR; PG8_WAIT_L(0); PG8_MMA(1, 0, At, B0); PG8_BAR; PG8_SCHED;
            PG8_STAGE(PG8_SB(0, 1), b2 + hstep, voffB);
            PG8_WAIT_V(6); PG8_BAR; PG8_MMA(1, 1, At, B1); PG8_BAR;
            PG8_LDB(B0, 1, 0); PG8_SCHED; PG8_LDA(At, 1, 0); PG8_STAGE_A(PG8_SA(0, 1), a2, 1, last);
            PG8_WAIT_L(8); PG8_BAR; PG8_WAIT_L(0); PG8_MMA(0, 0, At, B0); PG8_BAR; PG8_SCHED;
            PG8_LDB(B1, 1, 1); PG8_STAGE(PG8_SB(1, 0), b3, voffB);
            PG8_BAR; PG8_WAIT_L(0); PG8_MMA(0, 1, At, B1); PG8_BAR;
            PG8_LDA(At, 1, 1); PG8_STAGE_A(PG8_SA(1, 0), a3, 0, last);
            PG8_BAR; PG8_WAIT_L(0); PG8_MMA(1, 0, At, B0); PG8_BAR; PG8_SCHED;
            PG8_STAGE(PG8_SB(1, 1), b3 + hstep, voffB);
            PG8_WAIT_V(6); PG8_BAR; PG8_MMA(1, 1, At, B1); PG8_BAR;
            }
        }
        if constexpr (ALIGN_EPI) { if (wr == 0) PG8_BAR; }
        if constexpr (!Epi::AFTER_DRAIN) { E(acc, cur, wr, wc, fr, fq); S.done(cur); }
        if (!has_next) break;
#pragma unroll
        for (int a = 0; a < 2; ++a)
#pragma unroll
            for (int b = 0; b < 2; ++b)
#pragma unroll
                for (int m = 0; m < 4; ++m)
#pragma unroll
                    for (int n = 0; n < 2; ++n) acc[a][b][m][n] = (f32x4){0.f, 0.f, 0.f, 0.f};
        cur = nxt; cA = nA; cB = nB; ++ui;
        if constexpr (GATHER) {
#pragma unroll
            for (int h = 0; h < 2; ++h)
#pragma unroll
                for (int i = 0; i < 2; ++i) gc[h][i] = gn[h][i]; }
        if constexpr (ALIGN_EPI) { if (wr == 1) PG8_BAR; }
    }
    PG8_WAIT_V(0);
    if constexpr (!ALIGN_EPI) { if (wr == 0) PG8_BAR; }
    PG8_BAR;
    if constexpr (Epi::AFTER_DRAIN) { E.fused(acc, cur, wr, wc, fr, fq, lds, wid, lane); S.done(cur); }
#undef PG8_SA
#undef PG8_SB
#undef PG8_STAGE
#undef PG8_STAGE_A
#undef PG8_LDA
#undef PG8_LDB
#undef PG8_MMA
#undef PG8_WAIT_V
#undef PG8_WAIT_L
#undef PG8_BAR
#undef PG8_SCHED
}
}

constexpr int NWAVES = 8, NTHR = 512;
constexpr int RING_BYTES = 131072;
constexpr int LDSCTL_OFF = 161792, MISC_OFF = LDSCTL_OFF + 320;
constexpr int LDS_BYTES = 163840;
constexpr size_t WS_WIN0 = 8 * MiB, WS_WOUT0 = 13 * MiB, WS_WIN1 = 15 * MiB, WS_WOUT1 = 18 * MiB, WS_WGU = 20 * MiB  , WS_WD = 52 * MiB  ;
constexpr size_t WS_ROPEC = 2 * MiB, WS_ROPES = 2 * MiB + 256 * 1024, WS_BIN0P = 2 * MiB + 512 * 1024;
constexpr size_t CTL_ZERO_BYTES = 336 * 1024;
constexpr int CW_BAR = 4096;

#define GAS __attribute__((address_space(1)))
#define LAS __attribute__((address_space(3)))
typedef unsigned v4u __attribute__((ext_vector_type(4)));
typedef unsigned v2u __attribute__((ext_vector_type(2)));
typedef float f32x4 __attribute__((ext_vector_type(4)));
typedef GAS unsigned gu32;
#define RLX_AGENT __ATOMIC_RELAXED, __HIP_MEMORY_SCOPE_AGENT
#define LDS_WAIT() asm volatile("s_waitcnt lgkmcnt(0)" ::: "memory")
__device__ __forceinline__ unsigned pk2(float lo, float hi) { typedef float f2_t __attribute__((ext_vector_type(2))); typedef __bf16 b2_t __attribute__((ext_vector_type(2)));
    f2_t v = {lo, hi}; b2_t b = __builtin_convertvector(v, b2_t); return __builtin_bit_cast(unsigned, b); }
__device__ __forceinline__ f32x4 unpk4(v2u b) { f32x4 o; o[0] = __uint_as_float(b.x << 16); o[1] = __uint_as_float(b.x & 0xffff0000u); o[2] = __uint_as_float(b.y << 16); o[3] = __uint_as_float(b.y & 0xffff0000u); return o; }
constexpr size_t WS_LIST = 484 * MiB, WS_LISTW = 489 * MiB;
constexpr size_t WS_CTXKV = 72 * MiB;
constexpr size_t WS_HB = 412 * MiB;

#define XB_TMO      128
#define XB_XCNT(j)  (256  + 64 * (j))
#define XB_XSUB(j)  (1280 + 64 * (j))
#define XB_XGEN(j)  (2304 + 64 * (j))
#define XB_TOP      3328
#define XB_TOPGEN   3392
#define XCD_BAR_WORDS 3456
#define XB_SPIN_CAP (1u << 18)

__device__ __forceinline__ unsigned xb_ld(unsigned* p)              { return __hip_atomic_load(p, __ATOMIC_RELAXED, __HIP_MEMORY_SCOPE_AGENT); }
__device__ __forceinline__ unsigned xb_add(unsigned* p, unsigned v) { return __hip_atomic_fetch_add(p, v, __ATOMIC_RELAXED, __HIP_MEMORY_SCOPE_AGENT); }
__device__ __forceinline__ unsigned xb_xcc_id() { return (unsigned)__builtin_amdgcn_s_getreg((3 << 11) | 20) & 0xFu; }
#define XB_SPIN(cond, bar) do { unsigned _sp = 0; while (cond) { __builtin_amdgcn_s_sleep(1); \
    if ((++_sp & 255u) == 0u) { if (xb_ld(&(bar)[XB_TMO])) break; if (_sp > XB_SPIN_CAP) { atomicAdd(&(bar)[XB_TMO], 1u); break; } } } } while (0)

struct XcdBarrier {
    unsigned* bar; unsigned x;
    volatile LAS unsigned* st;
};

__device__ __forceinline__ XcdBarrier xcd_barrier_post(unsigned* bar, volatile LAS unsigned* st) {
    XcdBarrier b; b.bar = bar; b.x = xb_xcc_id(); b.st = st;
    if (threadIdx.x == 0) (void)xb_add(&bar[XB_XCNT(b.x)], 1u);
    return b;
}
__device__ __forceinline__ void xcd_barrier_complete(unsigned* bar, unsigned x, unsigned& nloc, unsigned& nx) {
    const unsigned G = gridDim.x * gridDim.y * gridDim.z;
    unsigned sum, cnt, mine, sp = 0u;
    for (;;) {
        sum = 0u; cnt = 0u; mine = 0u;
#pragma unroll
        for (unsigned j = 0; j < 16; ++j) { const unsigned c = xb_ld(&bar[XB_XCNT(j)]); sum += c; cnt += (c > 0u) ? 1u : 0u; mine = (j == x) ? c : mine; }
        if (sum == G) break;
        __builtin_amdgcn_s_sleep(1);
        if ((++sp & 255u) == 0u) { if (xb_ld(&bar[XB_TMO])) break; if (sp > XB_SPIN_CAP) { atomicAdd(&bar[XB_TMO], 1u); break; } }
    }
    nloc = mine > 0u ? mine : 1u; nx = cnt > 0u ? cnt : 1u;
}

__device__ __forceinline__ void xcd_barrier(const XcdBarrier& b) {
    asm volatile("s_waitcnt vmcnt(0)" ::: "memory");
    __syncthreads();
    if (threadIdx.x == 0) {
        unsigned* bar = b.bar;
        __builtin_amdgcn_s_waitcnt(0);
        unsigned nloc = b.st[0], nx = b.st[1];
        if (nloc == 0u) { xcd_barrier_complete(bar, b.x, nloc, nx); b.st[0] = nloc; b.st[1] = nx; }
        const unsigned old = xb_add(&bar[XB_XSUB(b.x)], 1u);
        const unsigned gen = old / nloc;
        if (old + 1u == (gen + 1u) * nloc) {
            __builtin_amdgcn_fence(__ATOMIC_RELEASE, "agent");
            asm volatile("s_waitcnt vmcnt(0)" ::: "memory");
            const unsigned og = xb_add(&bar[XB_TOP], 1u);
            const unsigned tgt = (gen + 1u) * nx;
            if (og + 1u < tgt) XB_SPIN(xb_ld(&bar[XB_TOP]) < tgt, bar);
            __builtin_amdgcn_fence(__ATOMIC_ACQUIRE, "agent");
            asm volatile("s_waitcnt vmcnt(0)" ::: "memory");
        } else {
            XB_SPIN(xb_ld(&bar[XB_TOP]) < (gen + 1u) * nx, bar);
            __builtin_amdgcn_fence(__ATOMIC_ACQUIRE, "agent");
            asm volatile("s_waitcnt vmcnt(0)" ::: "memory");
        }
    }
    __syncthreads();
}


struct Frame {
    LAS unsigned char* lds;
    volatile LAS unsigned* MISC;
    gu32* ctl;
    int tid, lane, wave, vcu, G;
};
struct Args { const float* in[25]; float* out; unsigned char* ws; int ph_lo, ph_hi, li, pad; };

template <int CTRL, int ROW_MASK> __device__ __forceinline__ float dpp_add(float v) {
    return v + __int_as_float(__builtin_amdgcn_update_dpp(0, __float_as_int(v), CTRL, ROW_MASK, 0xf, false));
}
__device__ __forceinline__ float wave_sum(float v) {
    v = dpp_add<0xB1, 0xf>(v);
    v = dpp_add<0x4E, 0xf>(v);
    v = dpp_add<0x141, 0xf>(v);
    v = dpp_add<0x140, 0xf>(v);
    v = dpp_add<0x142, 0xa>(v);
    v = dpp_add<0x143, 0xc>(v);
    return __int_as_float(__builtin_amdgcn_readlane(__float_as_int(v), 63));
}

__device__ __forceinline__ void phase_mods(Frame& F, const float* c, const float* c_ctx, const float* ada_w, const float* ada_b, float* MOD, float* ropeC, float* ropeS) {
    LAS float* S = (LAS float*)F.lds;
    LAS float* PART = (LAS float*)(F.lds + 17 * 1024 * 4);
    {
        f32x4 xv[9];
#pragma unroll
        for (int it = 0; it < 9; ++it) { const int i4 = F.tid + NTHR * it, b = i4 >> 8, k4 = i4 & 255;
            xv[it] = (f32x4){0.f, 0.f, 0.f, 0.f};
            if (i4 < 17 * 256) xv[it] = *(const f32x4*)(b < 16 ? c + b * 1024 + 4 * k4 : c_ctx + 4 * k4); }
#pragma unroll
        for (int it = 0; it < 9; ++it) { const int i4 = F.tid + NTHR * it;
            if (i4 < 17 * 256) { f32x4 y;
#pragma unroll
                for (int e = 0; e < 4; ++e) y[e] = xv[it][e] / (1.f + __expf(-xv[it][e]));
                *(LAS f32x4*)(S + 4 * i4) = y; } }
    }
    __syncthreads();
    for (int cb = F.vcu; cb < 256; cb += F.G) {
        const int l = cb >> 7, col0 = (cb & 127) * 48;
        {
            const int kq = F.lane & 3, c4 = F.lane >> 2;
            f32x4 acc[17];
#pragma unroll
            for (int b = 0; b < 17; ++b) acc[b] = (f32x4){0.f, 0.f, 0.f, 0.f};
            if (c4 < 12) {
                const float* wp = ada_w + ((size_t)l * 1024 + F.wave * 128 + kq) * 6144 + col0 + 4 * c4;
                f32x4 wv[4], wn[4];
#pragma unroll
                for (int q = 0; q < 4; ++q) wv[q] = __builtin_nontemporal_load((const f32x4*)(wp + (size_t)(4 * q) * 6144));
#pragma unroll 1
                for (int k0 = 0; k0 < 128; k0 += 16) {
                    if (k0 + 16 < 128) {
#pragma unroll
                        for (int q = 0; q < 4; ++q) wn[q] = __builtin_nontemporal_load((const f32x4*)(wp + (size_t)(k0 + 16 + 4 * q) * 6144)); }
#pragma unroll
                    for (int q = 0; q < 4; ++q) { const int k = F.wave * 128 + k0 + 4 * q + kq;
                        float sv[17];
#pragma unroll
                        for (int b = 0; b < 17; ++b) sv[b] = S[b * 1024 + k];
                        __builtin_amdgcn_sched_barrier(0);
#pragma unroll
                        for (int b = 0; b < 17; ++b) acc[b] += wv[q] * sv[b]; }
#pragma unroll
                    for (int q = 0; q < 4; ++q) wv[q] = wn[q]; }
            }
#pragma unroll
            for (int b = 0; b < 17; ++b)
#pragma unroll
                for (int e = 0; e < 4; ++e) acc[b][e] = dpp_add<0x4E, 0xf>(dpp_add<0xB1, 0xf>(acc[b][e]));
            if (kq == 0 && c4 < 12) {
#pragma unroll
                for (int b = 0; b < 17; ++b) *(LAS f32x4*)(PART + (F.wave * 17 + b) * 48 + 4 * c4) = acc[b]; }
        }
        __syncthreads();
        for (int idx = F.tid; idx < 17 * 48; idx += NTHR) { const int b = idx / 48, j = idx % 48; float s = 0.f;
#pragma unroll
            for (int w = 0; w < 8; ++w) s += PART[(w * 17 + b) * 48 + j];
            MOD[((size_t)l * 17 + b) * 6144 + col0 + j] = s + ada_b[l * 6144 + col0 + j]; }
        __syncthreads();
    }
    for (int idx = F.vcu * NTHR + F.tid; idx < 2048 * 32; idx += F.G * NTHR) {
        const int t = idx >> 5, e = idx & 31, a = e >> 4, i = e & 15;
        const float pos = (float)(a == 0 ? (t >> 6) : (t & 63));
        const float ang = pos * powf(10000.f, -(float)i / 16.f);
        ropeC[idx] = cosf(ang); ropeS[idx] = sinf(ang);
    }
}

__device__ __forceinline__ int rowmap(int mode, int n) {
    if (mode == 1) return 8 * (n >> 2) + (n & 3);
    if (mode == 2) return 8 * (n >> 2) + 4 + (n & 3);
    if (mode == 4) { if (n >= 1024) return n; const int c = n & 511; return 8 * (c >> 2) + (n >= 512 ? 4 : 0) + (c & 3); }
    if (mode == 3) { if (n >= 1280) return n; const int head = n >> 6, d = n & 63, a = d >> 5, p = (d >> 4) & 1, i = d & 15; return head * 64 + a * 32 + (i >> 2) * 8 + p * 4 + (i & 3); }
    return n;
}
__device__ __forceinline__ void transpose_item(const float* W, int N, bf16* WT, int K, int mode, LAS float* scr, int item, int lane) {
    const int nblk = N / 32, kb = item / nblk, nb = item % nblk, k0 = 64 * kb, n0 = 32 * nb;
    {
        const int kr = lane >> 3, c4 = 4 * (lane & 7);
        const float* src = W + (size_t)(k0 + kr) * N + n0 + c4;
        f32x4 v[8];
#pragma unroll
        for (int i = 0; i < 8; ++i) v[i] = __builtin_nontemporal_load((const f32x4*)(src + (size_t)(8 * i) * N));
#pragma unroll
        for (int i = 0; i < 8; ++i) { LAS float* d = scr + (8 * i + kr) * 33 + c4; d[0] = v[i][0]; d[1] = v[i][1]; d[2] = v[i][2]; d[3] = v[i][3]; }
    }
    LDS_WAIT(); asm volatile("" ::: "memory");
    const int c = lane & 7;
#pragma unroll
    for (int j = 0; j < 4; ++j) { const int n = (lane >> 3) + 8 * j; const LAS float* s = scr + (8 * c) * 33 + n;
        v4u o; o.x = pk2(s[0 * 33], s[1 * 33]); o.y = pk2(s[2 * 33], s[3 * 33]); o.z = pk2(s[4 * 33], s[5 * 33]); o.w = pk2(s[6 * 33], s[7 * 33]);
        *(GAS v4u*)(WT + (size_t)rowmap(mode, n0 + n) * K + k0 + 8 * c) = o; }
    LDS_WAIT(); asm volatile("" ::: "memory");
}
__device__ __forceinline__ void prep_items(Frame& F, const Args& A, int lo, int hi, int rank, int nworkers) {
    unsigned char* ws = A.ws;
    LAS float* scr = (LAS float*)(F.lds + F.wave * 16384);
    constexpr int NI_A = 1280, NI_B = NI_A + 512, NI_C = NI_B + 768, NI_D = NI_C + 512;
    for (int it = lo + rank * NWAVES + F.wave; it < hi; it += nworkers * NWAVES) {
        if (it < NI_A) { transpose_item(A.in[8], 2560, (bf16*)(ws + WS_WIN0), 1024, 4, scr, it, F.lane); continue; }
        if (it < NI_B) { transpose_item(A.in[15], 1024, (bf16*)(ws + WS_WOUT0), 1024, 0, scr, it - NI_A, F.lane); continue; }
        if (it < NI_C) { transpose_item(A.in[17], 1536, (bf16*)(ws + WS_WIN1), 1024, 3, scr, it - NI_B, F.lane); continue; }
        if (it < NI_D) { transpose_item(A.in[19], 1024, (bf16*)(ws + WS_WOUT1), 1024, 0, scr, it - NI_C, F.lane); continue; }
        const int r = it - NI_D, le = r / 384, which = (r % 384) >> 7, sub = r & 127;
        if (which == 0) transpose_item(A.in[22] + (size_t)le * 1024 * 256, 256, (bf16*)(ws + WS_WGU) + (size_t)le * 512 * 1024, 1024, 1, scr, sub, F.lane);
        else if (which == 1) transpose_item(A.in[23] + (size_t)le * 1024 * 256, 256, (bf16*)(ws + WS_WGU) + (size_t)le * 512 * 1024, 1024, 2, scr, sub, F.lane);
        else transpose_item(A.in[24] + (size_t)le * 256 * 1024, 1024, (bf16*)(ws + WS_WD) + (size_t)le * 1024 * 256, 256, 0, scr, sub, F.lane);
    }
}
__device__ __forceinline__ void tail_items(Frame& F, const Args& A, int nwg, int lo, int hi) {
    const int rem = nwg % F.G, rank = rem ? (int)blockIdx.x - rem : (int)blockIdx.x, nworkers = rem ? F.G - rem : F.G;
    if (rank >= 0) prep_items(F, A, lo, hi, rank, nworkers);
}
constexpr int PI_L0W = 1792, PI_EXP0 = 3072, PI_EXP1 = 9216, PI_ALL = 15360;
__device__ __forceinline__ void phase_prep(Frame& F, const Args& A) {
    unsigned char* ws = A.ws;
    prep_items(F, A, 0, PI_L0W, F.vcu, F.G);
    for (int n = F.vcu * NTHR + F.tid; n < 2560; n += F.G * NTHR) ((float*)(ws + WS_BIN0P))[rowmap(4, n)] = A.in[9][n];
    const float* MOD = (const float*)(ws + WS_MOD); bf16* ACT = (bf16*)(ws + WS_ACT);
    {
        const int RPB = (NT + F.G - 1) / F.G, r0 = F.vcu * RPB, nloc = min(RPB, max(0, NT - r0));
        f32x4 xN[4], sc[4], sh[4]; int cur_mr = -1;
        if (F.wave < nloc) { const int r = r0 + F.wave; const float* src = r < NL ? A.in[0] + (size_t)r * 1024 : A.in[2] + (size_t)(r - NL) * 1024;
#pragma unroll
            for (int j = 0; j < 4; ++j) xN[j] = __builtin_nontemporal_load((const f32x4*)(src + 4 * F.lane + 256 * j)); }
        for (int rl = F.wave; rl < nloc; rl += NWAVES) { const int r = r0 + rl; const int mr = mod_row(r);
            if (mr != cur_mr) { cur_mr = mr; const float* m = MOD + (size_t)mr * 6144;
#pragma unroll
                for (int j = 0; j < 4; ++j) { const int cc = 4 * F.lane + 256 * j; sc[j] = *(const f32x4*)(m + 1024 + cc) + 1.0f; sh[j] = *(const f32x4*)(m + cc); } }
            f32x4 u[4];
#pragma unroll
            for (int j = 0; j < 4; ++j) u[j] = xN[j] * sc[j] + sh[j];
            if (rl + NWAVES < nloc) { const int rn = r + NWAVES; const float* src = rn < NL ? A.in[0] + (size_t)rn * 1024 : A.in[2] + (size_t)(rn - NL) * 1024;
#pragma unroll
                for (int j = 0; j < 4; ++j) xN[j] = __builtin_nontemporal_load((const f32x4*)(src + 4 * F.lane + 256 * j)); }
#pragma unroll
            for (int j = 0; j < 4; ++j) { v2u o; o.x = pk2(u[j][0], u[j][1]); o.y = pk2(u[j][2], u[j][3]); *(v2u*)(ACT + (size_t)r * 1024 + 4 * F.lane + 256 * j) = o; } }
    }
}

constexpr size_t WS_TOKPOS = WS_TOKE;
constexpr size_t WS_SROWTOK = 4 * MiB, WS_SROWW = 4 * MiB + 512 * 1024;
constexpr int CW_CTXF = 40000 + 2 * 20480;
constexpr int CW_UPC = 40000;
constexpr int CW_CNT = 82000;
constexpr int MOE_LDS = LDSCTL_OFF + 1024;
constexpr int RPBMAX = 512;

template <int L_> __device__ __forceinline__ void moe_tiles(Frame& F) {
    LAS int* TS = (LAS int*)(F.lds + MOE_LDS);
    if (F.tid < 64) {
        int c = 0; if (F.tid < 16) c = (int)__hip_atomic_load(F.ctl + CW_CNT + L_ * 64 + F.tid, RLX_AGENT);
        const int t = (c + 255) >> 8; int incl = t;
#pragma unroll
        for (int o = 1; o < 16; o <<= 1) { const int v = __shfl_up(incl, o); if (F.lane >= o) incl += v; }
        if (F.tid < 16) { TS[F.tid] = incl - t; TS[32 + F.tid] = c; }
        if (F.tid == 15) TS[16] = incl; }
    __syncthreads();
}

template <int L_> __device__ __forceinline__ void phase_ln1(Frame& F, const Args& A, bool dry) {
    const float* hin_lat = A.in[0]; const float* hin_ctx = A.in[2]; bf16* HB = (bf16*)(A.ws + WS_HB);
    constexpr int nrows = L_ == 0 ? NT : NL;
    unsigned char* ws = A.ws;
    const float* MOD = (const float*)(ws + WS_MOD); const bf16* O = (const bf16*)(ws + WS_PROJ); bf16* ACT = (bf16*)(ws + WS_ACT);
    const float* lng = A.in[6] + (L_ * 2 + 0) * 1024; const float* lnb = A.in[7] + (L_ * 2 + 0) * 1024;
    LAS float* RW = (LAS float*)F.lds;
    LAS int* INFO_E = (LAS int*)(F.lds + 81920); LAS float* INFO_W0 = (LAS float*)(F.lds + 81920 + 2048); LAS float* INFO_W1 = (LAS float*)(F.lds + 81920 + 4096);
    LAS int* RANK = (LAS int*)(F.lds + 81920 + 6144); LAS int* CNTL = (LAS int*)(F.lds + 81920 + 8192); LAS int* BASEL = CNTL + 16;
    { const float* rg = A.in[20] + (size_t)L_ * 1024 * 4; const float* re = A.in[21] + (size_t)L_ * 1024 * 16;
      f32x4 ra[2], rb[8];
#pragma unroll
      for (int it = 0; it < 2; ++it) ra[it] = *(const f32x4*)(rg + 4 * (F.tid + NTHR * it));
#pragma unroll
      for (int it = 0; it < 8; ++it) rb[it] = *(const f32x4*)(re + 4 * (F.tid + NTHR * it));
#pragma unroll
      for (int it = 0; it < 2; ++it) { const int k = F.tid + NTHR * it;
#pragma unroll
          for (int g = 0; g < 4; ++g) RW[g * 1024 + k] = ra[it][g]; }
#pragma unroll
      for (int it = 0; it < 8; ++it) { const int i4 = F.tid + NTHR * it, k = i4 >> 2, e4 = i4 & 3;
#pragma unroll
          for (int q = 0; q < 4; ++q) RW[(4 + 4 * e4 + q) * 1024 + k] = rb[it][q]; } }
    if (F.tid < 16) CNTL[F.tid] = 0;
    __syncthreads();
    const int RPB = (nrows + F.G - 1) / F.G, r0 = F.vcu * RPB, nloc = min(RPB, max(0, nrows - r0));
    f32x4 hN[4]; v2u hB[4], oN[4];
    if (F.wave < nloc) { const int r = r0 + F.wave; const float* hin = r < NL ? hin_lat + (size_t)r * 1024 : hin_ctx + (size_t)(r - NL) * 1024;
#pragma unroll
        for (int j = 0; j < 4; ++j) { const int cc = 4 * F.lane + 256 * j; if (L_ == 0) hN[j] = __builtin_nontemporal_load((const f32x4*)(hin + cc)); else hB[j] = __builtin_nontemporal_load((const v2u*)(HB + (size_t)r * 1024 + cc)); oN[j] = __builtin_nontemporal_load((const v2u*)(O + (size_t)r * 1024 + cc)); } }
    f32x4 lg[4], lb[4], mg2[4], mm4[4], mm3[4]; int cur_mr = -1;
#pragma unroll
    for (int j = 0; j < 4; ++j) { const int cc = 4 * F.lane + 256 * j; lg[j] = *(const f32x4*)(lng + cc); lb[j] = *(const f32x4*)(lnb + cc); }
    for (int rl = F.wave; rl < nloc; rl += NWAVES) {
        const int r = r0 + rl;
        bf16* hout = dry ? (bf16*)(ws + WS_CAT) + (size_t)r * 1024 : HB + (size_t)r * 1024;
        const int mr = mod_row(r);
        if (mr != cur_mr) { cur_mr = mr; const float* m = MOD + (size_t)(L_ * 17 + mr) * 6144;
#pragma unroll
            for (int j = 0; j < 4; ++j) { const int cc = 4 * F.lane + 256 * j; mg2[j] = *(const f32x4*)(m + 2048 + cc); mm4[j] = *(const f32x4*)(m + 4096 + cc) + 1.0f; mm3[j] = *(const f32x4*)(m + 3072 + cc); } }
        f32x4 v[4]; float s = 0.f;
#pragma unroll
        for (int j = 0; j < 4; ++j) { const v2u ob = oN[j];
            f32x4 o4; o4[0] = __uint_as_float(ob.x << 16); o4[1] = __uint_as_float(ob.x & 0xffff0000u); o4[2] = __uint_as_float(ob.y << 16); o4[3] = __uint_as_float(ob.y & 0xffff0000u);
            v[j] = (L_ == 0 ? hN[j] : unpk4(hB[j])) * ALPHA + mg2[j] * o4; s += (v[j][0] + v[j][1]) + (v[j][2] + v[j][3]); }
        const float mean = wave_sum(s) * (1.f / 1024.f); float q = 0.f;
#pragma unroll
        for (int j = 0; j < 4; ++j) { v[j] = v[j] - mean; q += (v[j][0] * v[j][0] + v[j][1] * v[j][1]) + (v[j][2] * v[j][2] + v[j][3] * v[j][3]); }
        const float rstd = rsqrtf(wave_sum(q) * (1.f / 1024.f) + LN_EPS);
#pragma unroll
        for (int j = 0; j < 4; ++j) { const int cc = 4 * F.lane + 256 * j;
            const f32x4 h1 = v[j] * rstd * lg[j] + lb[j];
            { v2u hb; hb.x = pk2(h1[0], h1[1]); hb.y = pk2(h1[2], h1[3]); __builtin_nontemporal_store(hb, (v2u*)(hout + cc)); }
            const f32x4 tt = h1 * mm4[j] + mm3[j];
            v2u o; o.x = pk2(tt[0], tt[1]); o.y = pk2(tt[2], tt[3]); __hip_atomic_store((unsigned long long*)(ACT + (size_t)r * 1024 + cc), (unsigned long long)o.x | ((unsigned long long)o.y << 32), __ATOMIC_RELAXED, __HIP_MEMORY_SCOPE_AGENT);
            v[j] = tt; }
        if (rl + NWAVES < nloc) { const int rn = r + NWAVES; const float* hin = rn < NL ? hin_lat + (size_t)rn * 1024 : hin_ctx + (size_t)(rn - NL) * 1024;
#pragma unroll
            for (int j = 0; j < 4; ++j) { const int cc = 4 * F.lane + 256 * j; if (L_ == 0) hN[j] = __builtin_nontemporal_load((const f32x4*)(hin + cc)); else hB[j] = __builtin_nontemporal_load((const v2u*)(HB + (size_t)rn * 1024 + cc)); oN[j] = __builtin_nontemporal_load((const v2u*)(O + (size_t)rn * 1024 + cc)); } }
        float G[4], E4[4];
        { float pa[4];
#pragma unroll
          for (int k = 0; k < 4; ++k) { f32x4 a = {0.f, 0.f, 0.f, 0.f};
#pragma unroll
              for (int j = 0; j < 4; ++j) a += v[j] * *(const LAS f32x4*)(RW + k * 1024 + 4 * F.lane + 256 * j);
              pa[k] = (a[0] + a[1]) + (a[2] + a[3]); }
          const bool u5 = (F.lane & 32) != 0, u4 = (F.lane & 16) != 0;
          const float q0 = (u5 ? pa[2] : pa[0]) + __shfl_xor(u5 ? pa[0] : pa[2], 32), q1 = (u5 ? pa[3] : pa[1]) + __shfl_xor(u5 ? pa[1] : pa[3], 32);
          float q = (u4 ? q1 : q0) + __shfl_xor(u4 ? q0 : q1, 16);
          q += __shfl_xor(q, 8); q += __shfl_xor(q, 4); q += __shfl_xor(q, 2); q += __shfl_xor(q, 1);
#pragma unroll
          for (int k = 0; k < 4; ++k) G[k] = __int_as_float(__builtin_amdgcn_readlane(__float_as_int(q), 16 * k)); }
        int gi = 0; float gm = G[0];
#pragma unroll
        for (int i = 1; i < 4; ++i) if (G[i] > gm) { gm = G[i]; gi = i; }
        float gs = 0.f;
#pragma unroll
        for (int i = 0; i < 4; ++i) gs += __expf(G[i] - gm);
        const float gp = __builtin_amdgcn_rcpf(gs);
        { float pa[4]; const LAS float* RWg = RW + (4 + 4 * gi) * 1024;
#pragma unroll
          for (int k = 0; k < 4; ++k) { f32x4 a = {0.f, 0.f, 0.f, 0.f};
#pragma unroll
              for (int j = 0; j < 4; ++j) a += v[j] * *(const LAS f32x4*)(RWg + k * 1024 + 4 * F.lane + 256 * j);
              pa[k] = (a[0] + a[1]) + (a[2] + a[3]); }
          const bool u5 = (F.lane & 32) != 0, u4 = (F.lane & 16) != 0;
          const float q0 = (u5 ? pa[2] : pa[0]) + __shfl_xor(u5 ? pa[0] : pa[2], 32), q1 = (u5 ? pa[3] : pa[1]) + __shfl_xor(u5 ? pa[1] : pa[3], 32);
          float q = (u4 ? q1 : q0) + __shfl_xor(u4 ? q0 : q1, 16);
          q += __shfl_xor(q, 8); q += __shfl_xor(q, 4); q += __shfl_xor(q, 2); q += __shfl_xor(q, 1);
#pragma unroll
          for (int k = 0; k < 4; ++k) E4[k] = __int_as_float(__builtin_amdgcn_readlane(__float_as_int(q), 16 * k)); }
        int i0 = 0; float e0 = E4[0];
#pragma unroll
        for (int i = 1; i < 4; ++i) if (E4[i] > e0) { e0 = E4[i]; i0 = i; }
        int i1 = 0; float e1 = -3e38f;
#pragma unroll
        for (int i = 0; i < 4; ++i) if (i != i0 && E4[i] > e1) { e1 = E4[i]; i1 = i; }
        const float x1 = __expf(e1 - e0), rx = gp * __builtin_amdgcn_rcpf(1.f + x1);
        if (F.lane == 0) { INFO_E[rl] = (gi * 4 + i0) | ((gi * 4 + i1) << 8); INFO_W0[rl] = rx; INFO_W1[rl] = rx * x1; }
    }
    __syncthreads();
    for (int rl = F.tid; rl < nloc; rl += NTHR) { const int ee = INFO_E[rl];
        const int k0 = __hip_atomic_fetch_add(CNTL + (ee & 255), 1, __ATOMIC_RELAXED, __HIP_MEMORY_SCOPE_WORKGROUP);
        const int k1 = __hip_atomic_fetch_add(CNTL + (ee >> 8), 1, __ATOMIC_RELAXED, __HIP_MEMORY_SCOPE_WORKGROUP);
        RANK[rl] = k0 | (k1 << 16); }
    __syncthreads();
    if (dry) return;
    if (F.tid < 16) BASEL[F.tid] = (int)__hip_atomic_fetch_add(F.ctl + CW_CNT + L_ * 64 + F.tid, (unsigned)CNTL[F.tid], RLX_AGENT);
    __syncthreads();
    int* LIST = (int*)(ws + WS_LIST); float* LISTW = (float*)(ws + WS_LISTW);
    for (int rl = F.tid; rl < nloc; rl += NTHR) { const int ee = INFO_E[rl], rk = RANK[rl], e0 = ee & 255, e1 = ee >> 8; const int s = (r0 + rl) * 2;
        const size_t i0 = (size_t)e0 * pg8::MOE_CAP + BASEL[e0] + (rk & 0xffff), i1 = (size_t)e1 * pg8::MOE_CAP + BASEL[e1] + (rk >> 16);
        LIST[i0] = s; LISTW[i0] = INFO_W0[rl]; LIST[i1] = s + 1; LISTW[i1] = INFO_W1[rl]; }
}

template <int L_> __device__ __forceinline__ void phase_ln2(Frame& F, const Args& A, bool dry) {
    bf16* HB = (bf16*)(A.ws + WS_HB);
    constexpr int nrows = L_ == 0 ? NT : NL;
    unsigned char* ws = A.ws;
    const float* MOD = (const float*)(ws + WS_MOD); const bf16* YP = (const bf16*)(ws + WS_PROJ); bf16* ACT = (bf16*)(ws + WS_ACT);
    const float* lng = A.in[6] + (L_ * 2 + 1) * 1024; const float* lnb = A.in[7] + (L_ * 2 + 1) * 1024;
    constexpr int LN2_RH = 60, LN2_RL = 138;
    int r0, nloc, lat0 = 0;
    if (L_ == 0) { const int c = F.vcu, nh = (c >> 5) * 4 + min(c & 31, 4); const bool heavy = (c & 31) < 4;
        lat0 = nh * LN2_RH + (c - nh) * LN2_RL; const int nlat = min(heavy ? LN2_RH : LN2_RL, max(0, NL - lat0)); r0 = NL + 16 * c; nloc = 16 + nlat; }
    else { const int RPB = (nrows + F.G - 1) / F.G; r0 = F.vcu * RPB; nloc = min(RPB, max(0, nrows - r0)); }
#define LN2_ROW(rl_) ((L_ == 0 && (rl_) >= 16) ? lat0 + (rl_) - 16 : r0 + (rl_))
    v2u hB[4], yN[4], zN[4];
    if (F.wave < nloc) { const int r = LN2_ROW(F.wave);
#pragma unroll
        for (int j = 0; j < 4; ++j) { const int cc = 4 * F.lane + 256 * j; hB[j] = __builtin_nontemporal_load((const v2u*)(HB + (size_t)r * 1024 + cc)); yN[j] = __builtin_nontemporal_load((const v2u*)(YP + (size_t)r * 1024 + cc)); zN[j] = __builtin_nontemporal_load((const v2u*)(YP + ((size_t)NT + r) * 1024 + cc)); } }
    f32x4 lg[4], lb[4], mg5[4], ms1[4], mh0[4]; int cur_mr = -1;
#pragma unroll
    for (int j = 0; j < 4; ++j) { const int cc = 4 * F.lane + 256 * j; lg[j] = *(const f32x4*)(lng + cc); lb[j] = *(const f32x4*)(lnb + cc); }
    for (int rl = F.wave; rl < nloc; rl += NWAVES) {
        const int r = LN2_ROW(rl);
        const int mr = mod_row(r);
        if (mr != cur_mr) { cur_mr = mr; const float* m = MOD + (size_t)(L_ * 17 + mr) * 6144; const float* m1 = MOD + (size_t)(1 * 17 + mr) * 6144;
#pragma unroll
            for (int j = 0; j < 4; ++j) { const int cc = 4 * F.lane + 256 * j; mg5[j] = *(const f32x4*)(m + 5120 + cc); ms1[j] = *(const f32x4*)(m1 + 1024 + cc) + 1.0f; mh0[j] = *(const f32x4*)(m1 + cc); } }
        f32x4 v[4]; float s = 0.f;
#pragma unroll
        for (int j = 0; j < 4; ++j) { const v2u y0 = yN[j], y1 = zN[j];
            f32x4 y4; y4[0] = __uint_as_float(y0.x << 16) + __uint_as_float(y1.x << 16); y4[1] = __uint_as_float(y0.x & 0xffff0000u) + __uint_as_float(y1.x & 0xffff0000u);
            y4[2] = __uint_as_float(y0.y << 16) + __uint_as_float(y1.y << 16); y4[3] = __uint_as_float(y0.y & 0xffff0000u) + __uint_as_float(y1.y & 0xffff0000u);
            v[j] = unpk4(hB[j]) * ALPHA + mg5[j] * y4; s += (v[j][0] + v[j][1]) + (v[j][2] + v[j][3]); }
        if (rl + NWAVES < nloc) { const int rn = LN2_ROW(rl + NWAVES);
#pragma unroll
            for (int j = 0; j < 4; ++j) { const int cc = 4 * F.lane + 256 * j; hB[j] = __builtin_nontemporal_load((const v2u*)(HB + (size_t)rn * 1024 + cc)); yN[j] = __builtin_nontemporal_load((const v2u*)(YP + (size_t)rn * 1024 + cc)); zN[j] = __builtin_nontemporal_load((const v2u*)(YP + ((size_t)NT + rn) * 1024 + cc)); } }
        const float mean = wave_sum(s) * (1.f / 1024.f); float q = 0.f;
#pragma unroll
        for (int j = 0; j < 4; ++j) { v[j] = v[j] - mean; q += (v[j][0] * v[j][0] + v[j][1] * v[j][1]) + (v[j][2] * v[j][2] + v[j][3] * v[j][3]); }
        const float rstd = rsqrtf(wave_sum(q) * (1.f / 1024.f) + LN_EPS);
#pragma unroll
        for (int j = 0; j < 4; ++j) { const int cc = 4 * F.lane + 256 * j;
            const f32x4 h2 = v[j] * rstd * lg[j] + lb[j];
            if (L_ == 1) { __builtin_nontemporal_store(h2, (f32x4*)((dry ? (float*)(ws + WS_CAT) + (size_t)(r & 16383) * 1024 : A.out + (size_t)r * 1024) + cc)); }
            else { v2u hb; hb.x = pk2(h2[0], h2[1]); hb.y = pk2(h2[2], h2[3]); __builtin_nontemporal_store(hb, (v2u*)((dry ? (bf16*)(ws + WS_CAT) : HB) + (size_t)r * 1024 + cc)); }
            if (L_ == 0) { const f32x4 u = h2 * ms1[j] + mh0[j];
                v2u o; o.x = pk2(u[0], u[1]); o.y = pk2(u[2], u[3]);
                if (rl < 16) __hip_atomic_store((unsigned long long*)(ACT + (size_t)r * 1024 + cc), (unsigned long long)o.x | ((unsigned long long)o.y << 32), __ATOMIC_RELAXED, __HIP_MEMORY_SCOPE_AGENT);
                else __hip_atomic_store((unsigned long long*)(ACT + (size_t)r * 1024 + cc), (unsigned long long)o.x | ((unsigned long long)o.y << 32), __ATOMIC_RELAXED, __HIP_MEMORY_SCOPE_AGENT); } }
        if (L_ == 0 && rl >= 8 && rl < 16) {
            asm volatile("s_waitcnt vmcnt(0)" ::: "memory");
            if (F.lane == 0) { LAS unsigned* lc = (LAS unsigned*)(F.lds + MOE_LDS) + 61;
                const unsigned old = __hip_atomic_fetch_add(lc, 1u, __ATOMIC_RELAXED, __HIP_MEMORY_SCOPE_WORKGROUP);
                if (old == 7u) { __hip_atomic_store(lc, 0u, __ATOMIC_RELAXED, __HIP_MEMORY_SCOPE_WORKGROUP);
                    __hip_atomic_fetch_add((unsigned*)(F.ctl + CW_CTXF) + 64 * (F.vcu >> 4), 1u, __ATOMIC_RELAXED, __HIP_MEMORY_SCOPE_AGENT); } } }
    }
#undef LN2_ROW
}

namespace att {
typedef short bf16x8 __attribute__((ext_vector_type(8)));
typedef float f32x16 __attribute__((ext_vector_type(16)));
typedef short s16x4 __attribute__((ext_vector_type(4)));
constexpr float LOG2E = 1.4426950408889634f, C2 = 0.125f * LOG2E;
constexpr int A_KV = 0;
constexpr int A_BT = 133120;
constexpr int A_WSF = 149504;
__device__ __forceinline__ int crow(int r, int hi) { return (r & 3) + 8 * (r >> 2) + 4 * hi; }
__device__ __forceinline__ s16x4 vtr(const LAS char* p) { return __builtin_bit_cast(s16x4, __builtin_amdgcn_ds_read_tr16_b64_v4i16((LAS s16x4*)p)); }
__device__ __forceinline__ unsigned cvtpk(float lo, float hi) { typedef float f2 __attribute__((ext_vector_type(2))); typedef __bf16 b2 __attribute__((ext_vector_type(2)));
    f2 v = {lo, hi}; b2 b = __builtin_convertvector(v, b2); return __builtin_bit_cast(unsigned, b); }

template <int NH> __device__ __forceinline__ void stage_dma(const bf16* base, int ld, int row0, int kcol0, int vcol0, LAS unsigned char* buf, int lane, int wave) {
    const bf16* kp = base + (size_t)(row0 + wave * 8 + (lane >> 3)) * ld + kcol0 + (((lane & 7) ^ ((4 * wave + (lane >> 4)) & 7)) << 3);
    const bf16* vp = base + (size_t)(row0 + 16 * (wave & 3) + (lane >> 2)) * ld + vcol0 + (wave >> 2) * 32 + (lane & 3) * 8;
#pragma unroll
    for (int hh = 0; hh < NH; ++hh) {
        __builtin_amdgcn_global_load_lds((const unsigned*)(kp + hh * 64), (LAS unsigned*)(buf + hh * 16384 + wave * 1024), 16, 0, 0);
        __builtin_amdgcn_global_load_lds((const unsigned*)(vp + hh * 64), (LAS unsigned*)(buf + hh * 16384 + 8192 + wave * 1024), 16, 0, 0);
    }
}
#define ATT_DRAIN_BAR() do { asm volatile("s_waitcnt vmcnt(0)" ::: "memory"); __syncthreads(); } while (0)
__device__ __forceinline__ float xhalf_max(float x) { const auto t = __builtin_amdgcn_permlane32_swap(__float_as_uint(x), __float_as_uint(x), false, false); return fmaxf(__uint_as_float(t[0]), __uint_as_float(t[1])); }
__device__ __forceinline__ float xhalf_sum(float x) { const auto t = __builtin_amdgcn_permlane32_swap(__float_as_uint(x), __float_as_uint(x), false, false); return __uint_as_float(t[0]) + __uint_as_float(t[1]); }

template <int KIND, bool NEGM, int EV = 0> __device__ __forceinline__ void att_step(const LAS unsigned char* img, const bf16x8 (&qr)[4], f32x16 (&o)[2], float& m, float& l, LAS float* wsf,
                                                            int r32, int hi, int lane, f32x16& negm, const f32x16& mi0, const f32x16& mi1, const LAS float* btl, int dq, bool band = false) {
    f32x16 p0, p1;
    const LAS unsigned char* kb = img + r32 * 128;
    bf16x8 kf[8];
#define ATT_KLOAD(d0_) { const unsigned ka = (unsigned)(__UINTPTR_TYPE__)kb + (unsigned)(((2 * (d0_) + hi) ^ ((r32 >> 1) & 7)) << 4); \
        asm volatile("ds_read_b128 %0, %1" : "=v"(kf[2 * (d0_)]) : "v"(ka) : "memory"); asm volatile("ds_read_b128 %0, %1 offset:4096" : "=v"(kf[2 * (d0_) + 1]) : "v"(ka) : "memory"); }
#define ATT_LGKM(n_) do { asm volatile("s_waitcnt lgkmcnt(" #n_ ")" ::: "memory"); __builtin_amdgcn_sched_barrier(0); } while (0)
    ATT_KLOAD(0) ATT_KLOAD(1)
    ATT_LGKM(2);
    p0 = __builtin_amdgcn_mfma_f32_32x32x16_bf16(kf[0], qr[0], NEGM ? negm : mi0, 0, 0, 0); p1 = __builtin_amdgcn_mfma_f32_32x32x16_bf16(kf[1], qr[0], NEGM ? negm : mi1, 0, 0, 0);
    ATT_KLOAD(2)
    ATT_LGKM(2);
    p0 = __builtin_amdgcn_mfma_f32_32x32x16_bf16(kf[2], qr[1], p0, 0, 0, 0); p1 = __builtin_amdgcn_mfma_f32_32x32x16_bf16(kf[3], qr[1], p1, 0, 0, 0);
    ATT_KLOAD(3)
    ATT_LGKM(2);
    p0 = __builtin_amdgcn_mfma_f32_32x32x16_bf16(kf[4], qr[2], p0, 0, 0, 0); p1 = __builtin_amdgcn_mfma_f32_32x32x16_bf16(kf[5], qr[2], p1, 0, 0, 0);
    ATT_LGKM(0);
    p0 = __builtin_amdgcn_mfma_f32_32x32x16_bf16(kf[6], qr[3], p0, 0, 0, 0); p1 = __builtin_amdgcn_mfma_f32_32x32x16_bf16(kf[7], qr[3], p1, 0, 0, 0);
#undef ATT_KLOAD
    if (KIND == 1) {
        const unsigned ba = (unsigned)(__UINTPTR_TYPE__)btl;
        typedef float f32x2_t __attribute__((ext_vector_type(2)));
        f32x2_t bt[16];
#pragma unroll
        for (int g = 0; g < 8; ++g) { asm volatile("ds_read2_b32 %0, %1 offset0:%c2 offset1:%c3" : "=v"(bt[g]) : "v"(ba), "i"((2 * g & 3) + 8 * (g >> 1)), "i"((2 * g & 3) + 8 * (g >> 1) + 1) : "memory");
                                      asm volatile("ds_read2_b32 %0, %1 offset0:%c2 offset1:%c3" : "=v"(bt[8 + g]) : "v"(ba), "i"((2 * g & 3) + 8 * (g >> 1) + 32), "i"((2 * g & 3) + 8 * (g >> 1) + 33) : "memory"); }
        ATT_LGKM(0);
#pragma unroll
        for (int r = 0; r < 16; ++r) { p0[r] += bt[r >> 1][r & 1]; p1[r] += bt[8 + (r >> 1)][r & 1]; }
    } else if (KIND == 2 || KIND == 3) {
        if (KIND == 2 || band) {
#pragma unroll
            for (int r = 0; r < 16; ++r) { const int k0 = (r & 3) + 8 * (r >> 2) + 4 * hi, k1 = k0 + 32;
                p0[r] = ((unsigned)(dq - k0 + 128) <= 256u) ? p0[r] : -INFINITY; p1[r] = ((unsigned)(dq - k1 + 128) <= 256u) ? p1[r] : -INFINITY; } }
    }
    float pinf = INFINITY; asm volatile("" : "+s"(pinf));
    float rm = __builtin_amdgcn_fmed3f(p0[0], p1[0], pinf);
#pragma unroll
    for (int r = 1; r < 16; ++r) rm = fmaxf(rm, __builtin_amdgcn_fmed3f(p0[r], p1[r], pinf));
    rm = xhalf_max(rm);
    if (NEGM) {
        if (__any(rm > 8.0f)) {
            const float dl = fmaxf(rm, 0.f), f = __builtin_amdgcn_exp2f(-dl);
            m += dl; l *= f; wsf[r32] = f;
#pragma unroll
            for (int r = 0; r < 16; ++r) { p0[r] -= dl; p1[r] -= dl; negm[r] -= dl; }
#pragma unroll
            for (int r = 0; r < 16; ++r) { const float fr = wsf[crow(r, hi)]; o[0][r] *= fr; o[1][r] *= fr; }
        }
    } else {
        if (__any(rm > m + 8.0f)) {
            const float mn = fmaxf(m, rm), f = __builtin_amdgcn_exp2f(m - mn);
            l *= f; m = mn; wsf[r32] = f;
#pragma unroll
            for (int r = 0; r < 16; ++r) { const float fr = wsf[crow(r, hi)]; o[0][r] *= fr; o[1][r] *= fr; }
        }
    }
    const int vb = (int)(unsigned)(__UINTPTR_TYPE__)(img + 8192) + ((lane >> 4) & 1) * 32 + (lane & 3) * 8 + (4 * hi + ((lane & 15) >> 2)) * 64;
    s16x4 lo[4], hh[4];
#pragma unroll
    for (int ks = 0; ks < EV; ++ks) {
        asm volatile("ds_read_b64_tr_b16 %0, %1 offset:%c2" : "=&v"(lo[ks]) : "v"(vb), "i"(ks * 1024) : "memory");
        asm volatile("ds_read_b64_tr_b16 %0, %1 offset:%c2" : "=&v"(hh[ks]) : "v"(vb), "i"(ks * 1024 + 512) : "memory"); }
    if (EV > 0) __builtin_amdgcn_sched_barrier(0);
    float sacc = 0.f;
#pragma unroll
    for (int r = 0; r < 16; ++r) { p0[r] = __builtin_amdgcn_exp2f(NEGM ? p0[r] : p0[r] - m); p1[r] = __builtin_amdgcn_exp2f(NEGM ? p1[r] : p1[r] - m); sacc += p0[r] + p1[r]; }
    l += sacc;
    v4u pw[4];
#pragma unroll
    for (int q = 0; q < 4; ++q) { pw[0][q] = cvtpk(p0[2 * q], p0[2 * q + 1]); pw[1][q] = cvtpk(p0[8 + 2 * q], p0[9 + 2 * q]);
                                  pw[2][q] = cvtpk(p1[2 * q], p1[2 * q + 1]); pw[3][q] = cvtpk(p1[8 + 2 * q], p1[9 + 2 * q]); }
    if (EV > 0) __builtin_amdgcn_sched_barrier(0);
#pragma unroll
    for (int ks = EV; ks < 4; ++ks) {
        asm volatile("ds_read_b64_tr_b16 %0, %1 offset:%c2" : "=&v"(lo[ks]) : "v"(vb), "i"(ks * 1024) : "memory");
        asm volatile("ds_read_b64_tr_b16 %0, %1 offset:%c2" : "=&v"(hh[ks]) : "v"(vb), "i"(ks * 1024 + 512) : "memory"); }
    if (EV > 0 && EV < 4) {
        asm volatile("s_waitcnt lgkmcnt(%c0)" :: "i"(2 * (4 - EV)) : "memory"); __builtin_amdgcn_sched_barrier(0);
#pragma unroll
        for (int ks = 0; ks < EV; ++ks) {
            const bf16x8 vf = {lo[ks][0], lo[ks][1], lo[ks][2], lo[ks][3], hh[ks][0], hh[ks][1], hh[ks][2], hh[ks][3]};
            o[0] = __builtin_amdgcn_mfma_f32_32x32x16_bf16(__builtin_bit_cast(bf16x8, pw[ks]), vf, o[0], 0, 0, 0); }
    }
    asm volatile("s_waitcnt lgkmcnt(0)" ::: "memory"); __builtin_amdgcn_sched_barrier(0);
#pragma unroll
    for (int ks = (EV > 0 && EV < 4) ? EV : 0; ks < 4; ++ks) {
        const bf16x8 vf = {lo[ks][0], lo[ks][1], lo[ks][2], lo[ks][3], hh[ks][0], hh[ks][1], hh[ks][2], hh[ks][3]};
        o[0] = __builtin_amdgcn_mfma_f32_32x32x16_bf16(__builtin_bit_cast(bf16x8, pw[ks]), vf, o[0], 0, 0, 0); }
    __builtin_amdgcn_sched_barrier(0);
#pragma unroll
    for (int ks = 0; ks < 4; ++ks) {
        asm volatile("ds_read_b64_tr_b16 %0, %1 offset:%c2" : "=&v"(lo[ks]) : "v"(vb), "i"(4096 + ks * 1024) : "memory");
        asm volatile("ds_read_b64_tr_b16 %0, %1 offset:%c2" : "=&v"(hh[ks]) : "v"(vb), "i"(4096 + ks * 1024 + 512) : "memory"); }
    asm volatile("s_waitcnt lgkmcnt(0)" ::: "memory"); __builtin_amdgcn_sched_barrier(0);
#pragma unroll
    for (int ks = 0; ks < 4; ++ks) {
        const bf16x8 vf = {lo[ks][0], lo[ks][1], lo[ks][2], lo[ks][3], hh[ks][0], hh[ks][1], hh[ks][2], hh[ks][3]};
        o[1] = __builtin_amdgcn_mfma_f32_32x32x16_bf16(__builtin_bit_cast(bf16x8, pw[ks]), vf, o[1], 0, 0, 0); }
}
__device__ __forceinline__ void att_store(const f32x16 (&o)[2], float l, LAS float* wsf, LAS unsigned char* stgb, bf16* O, int ldo, int orow_base, int ocol, int r32, int hi, int lane, bool pair16 = false) {
    const float lt = xhalf_sum(l);
    wsf[r32] = __builtin_amdgcn_rcpf(lt);
    LAS bf16* stg = (LAS bf16*)stgb;
#pragma unroll
    for (int r = 0; r < 16; ++r) { const int orow = crow(r, hi); const float rl = wsf[orow];
        stg[orow * 64 + r32] = (bf16)pk2(o[0][r] * rl, 0.f); stg[orow * 64 + 32 + r32] = (bf16)pk2(o[1][r] * rl, 0.f); }
#pragma unroll
    for (int i = 0; i < 4; ++i) { const int row = i * 8 + (lane >> 3), ch = lane & 7;
        const v4u v = *(const LAS v4u*)(stg + row * 64 + ch * 8);
        *(v4u*)(O + (size_t)(orow_base + row + (pair16 ? (row >> 4) * 48 : 0)) * ldo + ocol + ch * 8) = v; }
}

template <bool NA> __device__ __forceinline__ void na_unit(Frame& F, const bf16* P, const float* rpb, bf16* CAT, int b, int gr, int hg, bool nodma = false) {
    const int lane = F.lane, wave = F.wave, r32 = lane & 31, hi = lane >> 5, hsel = wave >> 1, half = wave & 1, h = hg * 4 + hsel;
    const int rs = min(max(gr - 4, 0), 24);
    const int qrow0 = (NA ? b * 2048 + gr * 64 : NL + b * 256 + gr * 64) + 32 * half;
    LAS float* wsf = (LAS float*)(F.lds + A_WSF) + wave * 64;
    LAS float* BT = (LAS float*)(F.lds + A_BT);
    constexpr int NS = NA ? 12 : 4;
    bf16x8 qr[4];
#pragma unroll
    for (int d0 = 0; d0 < 4; ++d0) qr[d0] = *(const bf16x8*)(P + (size_t)(qrow0 + r32) * 2560 + 1024 + h * 64 + d0 * 16 + hi * 8);
    f32x16 o[2];
#pragma unroll
    for (int r = 0; r < 16; ++r) { o[0][r] = 0.f; o[1][r] = 0.f; }
    float m = -1e30f, l = 0.f;
    const int j = 32 * half + r32;
    f32x16 mi0, mi1, negm;
    { const int cs = min(max(j - 8, 0), 48);
#pragma unroll
      for (int r = 0; r < 16; ++r) { const int k0 = (r & 3) + 8 * (r >> 2) + 4 * hi; negm[r] = 0.f; mi0[r] = (!NA || (unsigned)(k0 - cs) < 16u) ? 0.f : -INFINITY; mi1[r] = (!NA || (unsigned)(k0 + 32 - cs) < 16u) ? 0.f : -INFINITY; } }
    f32x16 zz;
#pragma unroll
    for (int r = 0; r < 16; ++r) zz[r] = 0.f;
    __syncthreads();
    if (NA) for (int idx = F.tid; idx < 4096; idx += NTHR) { const int hh = idx >> 10, ii = (idx >> 7) & 7, y = (idx & 127) - 48;
        BT[idx] = (y >= 0 && y <= 30) ? rpb[((hg * 4 + hh) * 15 + (rs + ii - gr + 7)) * 31 + y] * LOG2E : 0.f; }
    stage_dma<4>(P, 2560, NL + b * 256, 1536 + hg * 256, 2048 + hg * 256, F.lds + A_KV, lane, wave);
    ATT_DRAIN_BAR();
    const LAS float* btl0 = BT + hsel * 1024 + (4 * hi - j + 63);
    for (int t = 0; t < NS; ++t) {
        const LAS unsigned char* img = F.lds + A_KV + (t & 1) * 65536 + hsel * 16384;
        if (t + 1 < NS && !nodma) { const int row0 = (t + 1 < 4) ? NL + b * 256 + 64 * (t + 1) : b * 2048 + (rs + t + 1 - 4) * 64;
            stage_dma<4>(P, 2560, row0, 1536 + hg * 256, 2048 + hg * 256, F.lds + A_KV + ((t + 1) & 1) * 65536, lane, wave); }
        if (t < 4) att_step<0, false, 4>(img, qr, o, m, l, wsf, r32, hi, lane, negm, zz, zz, nullptr, 0);
        else att_step<1, false, 4>(img, qr, o, m, l, wsf, r32, hi, lane, negm, mi0, mi1, btl0 + (t - 4) * 128, 0);
        ATT_DRAIN_BAR();
    }
    att_store(o, l, wsf, F.lds + A_KV + wave * 4096, CAT, 1024, qrow0, 512 + h * 64, r32, hi, lane);
}

__device__ __forceinline__ void att_step32(const LAS unsigned char* img, int W0, const bf16x8 (&qr)[4], f32x16 (&o)[2], float& m, float& l, LAS float* wsf,
                                           int r32, int hi, int lane, f32x16& mim, const LAS float* btl, bool rowok) {
    f32x16 p0;
    const unsigned kb = (unsigned)(__UINTPTR_TYPE__)(img + (W0 + r32) * 128); const int sw = ((W0 + r32) >> 1) & 7;
    bf16x8 kf[4];
#pragma unroll
    for (int d0 = 0; d0 < 4; ++d0) { const unsigned ka = kb + (unsigned)(((2 * d0 + hi) ^ sw) << 4); asm volatile("ds_read_b128 %0, %1" : "=v"(kf[d0]) : "v"(ka) : "memory"); }
    ATT_LGKM(3);
    p0 = __builtin_amdgcn_mfma_f32_32x32x16_bf16(kf[0], qr[0], mim, 0, 0, 0);
    ATT_LGKM(2);
    p0 = __builtin_amdgcn_mfma_f32_32x32x16_bf16(kf[1], qr[1], p0, 0, 0, 0);
    ATT_LGKM(1);
    p0 = __builtin_amdgcn_mfma_f32_32x32x16_bf16(kf[2], qr[2], p0, 0, 0, 0);
    const unsigned ba = (unsigned)(__UINTPTR_TYPE__)btl;
    typedef float f32x2_t __attribute__((ext_vector_type(2)));
    f32x2_t bt[8];
#pragma unroll
    for (int g = 0; g < 8; ++g) asm volatile("ds_read2_b32 %0, %1 offset0:%c2 offset1:%c3" : "=v"(bt[g]) : "v"(ba), "i"((2 * g & 3) + 8 * (g >> 1)), "i"((2 * g & 3) + 8 * (g >> 1) + 1) : "memory");
    ATT_LGKM(8);
    p0 = __builtin_amdgcn_mfma_f32_32x32x16_bf16(kf[3], qr[3], p0, 0, 0, 0);
    ATT_LGKM(0);
#pragma unroll
    for (int r = 0; r < 16; ++r) p0[r] += bt[r >> 1][r & 1];
    float pinf = INFINITY; asm volatile("" : "+s"(pinf));
    float rm = __builtin_amdgcn_fmed3f(p0[0], p0[1], pinf);
#pragma unroll
    for (int r = 1; r < 8; ++r) rm = fmaxf(rm, __builtin_amdgcn_fmed3f(p0[2 * r], p0[2 * r + 1], pinf));
    rm = xhalf_max(rm);
    if (__any(rm > 8.0f)) {
        const float dl = fmaxf(rm, 0.f), f = __builtin_amdgcn_exp2f(-dl);
        l *= f; m += dl; wsf[r32] = f;
#pragma unroll
        for (int r = 0; r < 16; ++r) { p0[r] -= dl; mim[r] -= dl; }
#pragma unroll
        for (int r = 0; r < 16; ++r) { const float fr = wsf[crow(r, hi)]; o[0][r] *= fr; o[1][r] *= fr; }
    }
    const int vb = (int)(unsigned)(__UINTPTR_TYPE__)(img + 8192) + ((lane >> 4) & 1) * 32 + (lane & 3) * 8 + (W0 + 4 * hi + ((lane & 15) >> 2)) * 64;
    s16x4 lo[4], hh[4];
#pragma unroll
    for (int ks = 0; ks < 2; ++ks) {
        asm volatile("ds_read_b64_tr_b16 %0, %1 offset:%c2" : "=&v"(lo[ks]) : "v"(vb), "i"(ks * 1024) : "memory");
        asm volatile("ds_read_b64_tr_b16 %0, %1 offset:%c2" : "=&v"(hh[ks]) : "v"(vb), "i"(ks * 1024 + 512) : "memory"); }
    __builtin_amdgcn_sched_barrier(0);
    float sacc = 0.f;
#pragma unroll
    for (int r = 0; r < 16; ++r) { p0[r] = __builtin_amdgcn_exp2f(p0[r]); sacc += p0[r]; }
    l += sacc;
    v4u pw[2];
#pragma unroll
    for (int q = 0; q < 4; ++q) { pw[0][q] = cvtpk(p0[2 * q], p0[2 * q + 1]); pw[1][q] = cvtpk(p0[8 + 2 * q], p0[9 + 2 * q]); }
    __builtin_amdgcn_sched_barrier(0);
#pragma unroll
    for (int ks = 0; ks < 2; ++ks) {
        asm volatile("ds_read_b64_tr_b16 %0, %1 offset:%c2" : "=&v"(lo[2 + ks]) : "v"(vb), "i"(4096 + ks * 1024) : "memory");
        asm volatile("ds_read_b64_tr_b16 %0, %1 offset:%c2" : "=&v"(hh[2 + ks]) : "v"(vb), "i"(4096 + ks * 1024 + 512) : "memory"); }
    ATT_LGKM(4);
#pragma unroll
    for (int ks = 0; ks < 2; ++ks) {
        const bf16x8 vf = {lo[ks][0], lo[ks][1], lo[ks][2], lo[ks][3], hh[ks][0], hh[ks][1], hh[ks][2], hh[ks][3]};
        o[0] = __builtin_amdgcn_mfma_f32_32x32x16_bf16(__builtin_bit_cast(bf16x8, pw[ks]), vf, o[0], 0, 0, 0); }
    ATT_LGKM(0);
#pragma unroll
    for (int ks = 0; ks < 2; ++ks) {
        const bf16x8 vf = {lo[2 + ks][0], lo[2 + ks][1], lo[2 + ks][2], lo[2 + ks][3], hh[2 + ks][0], hh[2 + ks][1], hh[2 + ks][2], hh[2 + ks][3]};
        o[1] = __builtin_amdgcn_mfma_f32_32x32x16_bf16(__builtin_bit_cast(bf16x8, pw[ks]), vf, o[1], 0, 0, 0); }
    __builtin_amdgcn_sched_barrier(0);
}
constexpr int A_BT2 = 133120;
__device__ __forceinline__ void na_pair_unit(Frame& F, const bf16* P, const float* rpb, bf16* CAT, int b, int gp, int hp, bool nodma, int& bt_hp) {
    const int lane = F.lane, wave = F.wave, r32 = lane & 31, hi = lane >> 5, hsel = wave >> 2, g = wave & 3, h = hp * 2 + hsel;
    const int gr0 = gp * 2, rsel = r32 >> 4, colq = 16 * g + (r32 & 15), grl = gr0 + rsel;
    const int rsU = min(max(gr0 - 4, 0), 24), rsV = min(max(gr0 - 3, 0), 24), nrows = rsV + 8 - rsU, NS = 4 + nrows;
    const int rsl = rsel ? rsV : rsU;
    const int W0 = g == 0 ? 0 : g == 1 ? 8 : g == 2 ? 24 : 32;
    LAS float* wsf = (LAS float*)(F.lds + A_WSF) + wave * 64;
    LAS float* BT = (LAS float*)(F.lds + A_BT2);
    bf16x8 qr[4];
#pragma unroll
    for (int d0 = 0; d0 < 4; ++d0) qr[d0] = *(const bf16x8*)(P + (size_t)(b * 2048 + grl * 64 + colq) * 2560 + 1024 + h * 64 + d0 * 16 + hi * 8);
    f32x16 o[2], mi, zz, negm;
    { const int cs = min(max(colq - 8, 0), 48);
#pragma unroll
      for (int r = 0; r < 16; ++r) { o[0][r] = 0.f; o[1][r] = 0.f; zz[r] = 0.f; negm[r] = 0.f; const int kc = W0 + (r & 3) + 8 * (r >> 2) + 4 * hi; mi[r] = ((unsigned)(kc - cs) < 16u) ? 0.f : -INFINITY; } }
    float m = -1e30f, l = 0.f;
    __syncthreads();
    if (bt_hp != hp) { bt_hp = hp;
        float bv[4];
#pragma unroll
        for (int it = 0; it < 4; ++it) { const int idx = F.tid + NTHR * it, hh = idx >> 10, ro = (idx >> 6) & 15, y = (idx & 63) - 16;
            bv[it] = ro == 15 ? -INFINITY : (y >= 0 && y <= 30) ? rpb[((hp * 2 + hh) * 15 + ro) * 31 + y] * LOG2E : 0.f; }
#pragma unroll
        for (int it = 0; it < 4; ++it) BT[F.tid + NTHR * it] = bv[it]; }
#define NA_ROW0(tt) (((tt) < 4) ? NL + b * 256 + 64 * (tt) : b * 2048 + (rsU + (tt) - 4) * 64)
    stage_dma<2>(P, 2560, NA_ROW0(0), 1536 + hp * 128, 2048 + hp * 128, F.lds + A_KV, lane, wave);
    stage_dma<2>(P, 2560, NA_ROW0(1), 1536 + hp * 128, 2048 + hp * 128, F.lds + A_KV + 32768, lane, wave);
    asm volatile("s_waitcnt vmcnt(4) lgkmcnt(0)\n\ts_barrier" ::: "memory");
    const LAS float* btl0 = BT + hsel * 1024 + (W0 + 4 * hi - colq + 31);
    int slot = 0;
#define NA_PRE(t_) const LAS unsigned char* img = F.lds + A_KV + slot * 32768 + hsel * 16384; \
        { const int s2 = slot == 0 ? 2 : slot - 1;                 \
          if ((t_) + 2 < NS) stage_dma<2>(P, 2560, NA_ROW0((t_) + 2), 1536 + hp * 128, 2048 + hp * 128, F.lds + A_KV + s2 * 32768, lane, wave); }
#define NA_POST(t_) do { if ((t_) + 2 < NS) asm volatile("s_waitcnt vmcnt(4) lgkmcnt(0)\n\ts_barrier" ::: "memory");     \
        else asm volatile("s_waitcnt vmcnt(0) lgkmcnt(0)\n\ts_barrier" ::: "memory"); \
        slot = slot == 2 ? 0 : slot + 1; } while (0)
#pragma unroll 1
    for (int t = 0; t < 4; ++t) { NA_PRE(t)
        att_step<0, false, 4>(img, qr, o, m, l, wsf, r32, hi, lane, negm, zz, zz, nullptr, 0);
        NA_POST(t); }
    f32x16 mim;
#pragma unroll
    for (int r = 0; r < 16; ++r) mim[r] = mi[r] - m;
#pragma unroll 1
    for (int t = 4; t < NS; ++t) { NA_PRE(t)
        const int wr = rsU + t - 4; const int ro = min(max(wr - grl + 7, 0), 14);
        att_step32(img, W0, qr, o, m, l, wsf, r32, hi, lane, mim, btl0 + ((unsigned)(wr - rsl) < 8u ? ro : 15) * 64, true);
        NA_POST(t); }
#undef NA_PRE
#undef NA_POST
#undef NA_ROW0
    att_store(o, l, wsf, F.lds + A_KV + wave * 4096, CAT, 1024, b * 2048 + gr0 * 64 + 16 * g, 512 + h * 64, r32, hi, lane, true);
}

constexpr int W_CTX = 0, W_RING = 65536, W_STG = 151552;
__device__ __forceinline__ void win_super(Frame& F, const bf16* QKV, const bf16* QKVC, const float* sink, bf16* CAT, int b, int hkv, int qg) {
    const int lane = F.lane, wave = F.wave, r32 = lane & 31, hi = lane >> 5, hq = hkv * 4 + (wave >> 1), half = wave & 1;
    LAS float* wsf = (LAS float*)(F.lds + A_WSF) + wave * 64;
    LAS bf16* stg = (LAS bf16*)(F.lds + W_STG + wave * 1024);
    const int kcol = 1024 + hkv * 64, vcol = 1280 + hkv * 64, qb0 = qg * 8;
    f32x16 dummy;
#pragma unroll
    for (int r = 0; r < 16; ++r) dummy[r] = 0.f;
    __syncthreads();
#pragma unroll
    for (int t = 0; t < 4; ++t) stage_dma<1>(QKVC, 1536, NL + b * 256 + 64 * t, kcol, vcol, F.lds + W_CTX + t * 16384, lane, wave);
    for (int jt = max(qb0 - 2, 0); jt <= min(qb0 + 2, 31); ++jt) stage_dma<1>(QKV, 1536, b * 2048 + jt * 64, kcol, vcol, F.lds + W_RING + (jt % 5) * 16384, lane, wave);
    bf16x8 qn[4];
#pragma unroll
    for (int d0 = 0; d0 < 4; ++d0) qn[d0] = *(const bf16x8*)(QKV + (size_t)(b * 2048 + qb0 * 64 + 32 * half + r32) * 1536 + hq * 64 + d0 * 16 + hi * 8);
    const float sk = sink[hq] * LOG2E;
    ATT_DRAIN_BAR();
    for (int i = 0; i < 8; ++i) {
        const int qb = qb0 + i, qrow0 = b * 2048 + qb * 64 + 32 * half, qpos = qb * 64 + 32 * half + r32;
        bf16x8 qr[4];
#pragma unroll
        for (int d0 = 0; d0 < 4; ++d0) qr[d0] = qn[d0];
        f32x16 o[2];
#pragma unroll
        for (int r = 0; r < 16; ++r) { o[0][r] = 0.f; o[1][r] = 0.f; }
        float m = sk, l = hi == 0 ? 1.f : 0.f;
        f32x16 negm;
#pragma unroll
        for (int r = 0; r < 16; ++r) negm[r] = -sk;
#pragma unroll 1
        for (int t = 0; t < 4; ++t) att_step<0, true>(F.lds + W_CTX + t * 16384, qr, o, m, l, wsf, r32, hi, lane, negm, dummy, dummy, nullptr, 0);
        const int jlo = max(qb - 2, 0), jhi = min(qb + 2, 31);
#pragma unroll 1
        for (int jt = jlo; jt <= jhi; ++jt) {
            const LAS unsigned char* img = F.lds + W_RING + (jt % 5) * 16384;
            att_step<3, true>(img, qr, o, m, l, wsf, r32, hi, lane, negm, dummy, dummy, nullptr, qpos - jt * 64, jt == qb - 2 || jt == qb + 2);
            if (jt == jlo && i < 7) {
                __syncthreads();
                if (qb + 3 <= 31) stage_dma<1>(QKV, 1536, b * 2048 + (qb + 3) * 64, kcol, vcol, F.lds + W_RING + ((qb + 3) % 5) * 16384, lane, wave);
            }
        }
        if (i < 7) {
#pragma unroll
            for (int d0 = 0; d0 < 4; ++d0) qn[d0] = *(const bf16x8*)(QKV + (size_t)(qrow0 + 64 + r32) * 1536 + hq * 64 + d0 * 16 + hi * 8);
        }
        { const float lt = xhalf_sum(l); wsf[r32] = __builtin_amdgcn_rcpf(lt);
#pragma unroll
          for (int g = 0; g < 4; ++g) {
#pragma unroll
              for (int rr = 0; rr < 4; ++rr) { const int r = 4 * g + rr; const float rl = wsf[crow(r, hi)]; const int lrow = rr + 4 * hi;
                  stg[lrow * 64 + r32] = (bf16)pk2(o[0][r] * rl, 0.f); stg[lrow * 64 + 32 + r32] = (bf16)pk2(o[1][r] * rl, 0.f); }
              const v4u v = *(const LAS v4u*)(stg + (lane >> 3) * 64 + (lane & 7) * 8);
              *(v4u*)(CAT + (size_t)(qrow0 + 8 * g + (lane >> 3)) * 1024 + hq * 64 + (lane & 7) * 8) = v; } }
        if (i < 7) ATT_DRAIN_BAR();
    }
}
}

__device__ __forceinline__ void conv_decode(int chunk, int& row_base, int& t0, int& L) {
    if (chunk < 1024) { row_base = chunk * 32; t0 = row_base & 2047; L = 2048; } else { const int cc = chunk - 1024; row_base = NL + cc * 32; t0 = (cc * 32) & 255; L = 256; }
}
__device__ __forceinline__ void conv_load(const bf16* P, int chunk, int tid, v4u (&pre)[8]) {
    int row_base, t0, L; conv_decode(chunk, row_base, t0, L);
    const int seq_base = row_base - t0;
#pragma unroll
    for (int it = 0; it < 8; ++it) { const int item = tid + NTHR * it, i = item >> 6, cg = item & 63, tt = t0 - 15 + i;
        v4u hw = {0u, 0u, 0u, 0u};
        if (item < 62 * 64 && tt >= 0 && tt < L) hw = *(const v4u*)(P + (size_t)(seq_base + tt) * 2560 + cg * 8);
        pre[it] = hw; }
}
typedef float cf2_t __attribute__((ext_vector_type(2)));
__device__ __forceinline__ void conv_chunk(Frame& F, const bf16* P, const cf2_t (&we)[15], const cf2_t (&wo)[15], float w0, float w30, float cb, const float* lng, const float* lnb, bf16* CAT, int chunk, int nxt, v4u (&pre)[8]) {
    int row_base, t0, L; conv_decode(chunk, row_base, t0, L);
    const int c = F.tid;
    LAS bf16* HG = (LAS bf16*)(F.lds + 65536);
#pragma unroll
    for (int it = 0; it < 8; ++it) { const int item = F.tid + NTHR * it; if (item < 62 * 64) *(LAS v4u*)(HG + (item >> 6) * 512 + (item & 63) * 8) = pre[it]; }
    asm volatile("s_waitcnt lgkmcnt(0)\n\ts_barrier" ::: "memory");
    if (nxt >= 0) conv_load(P, nxt, F.tid, pre);
    typedef float f2_t __attribute__((ext_vector_type(2)));
    f2_t E[31];
#pragma unroll
    for (int jj = 0; jj < 31; ++jj) { E[jj].x = bf2f(HG[(2 * jj) * 512 + c]); E[jj].y = bf2f(HG[(2 * jj + 1) * 512 + c]); }
    LAS float* CO = (LAS float*)F.lds;
#pragma unroll
    for (int tp = 0; tp < 16; ++tp) {
        f2_t a0 = {cb, 0.f}, a1 = {cb, 0.f};
#pragma unroll
        for (int q = 0; q < 15; ++q) { a0 = E[tp + q] * we[q] + a0; a1 = E[tp + 1 + q] * wo[q] + a1; }
        CO[(2 * tp) * 512 + c] = (a0.x + a0.y) + E[tp + 15].x * w30;
        CO[(2 * tp + 1) * 512 + c] = (a1.x + a1.y) + E[tp].y * w0; }
    asm volatile("s_waitcnt lgkmcnt(0)\n\ts_barrier" ::: "memory");
#pragma unroll
    for (int q = 0; q < 4; ++q) { const int tk = F.wave * 4 + q;
        const f32x4 x0 = *(const LAS f32x4*)(CO + tk * 512 + 8 * F.lane), x1 = *(const LAS f32x4*)(CO + tk * 512 + 8 * F.lane + 4);
        const float mean = wave_sum((x0[0] + x0[1]) + (x0[2] + x0[3]) + (x1[0] + x1[1]) + (x1[2] + x1[3])) * (1.f / 512.f);
        const f32x4 d0 = x0 - mean, d1 = x1 - mean;
        const float var = wave_sum((d0[0] * d0[0] + d0[1] * d0[1]) + (d0[2] * d0[2] + d0[3] * d0[3]) + (d1[0] * d1[0] + d1[1] * d1[1]) + (d1[2] * d1[2] + d1[3] * d1[3])) * (1.f / 512.f);
        const float rstd = rsqrtf(var + LN_EPS);
        const f32x4 y0 = d0 * rstd * *(const f32x4*)(lng + 8 * F.lane) + *(const f32x4*)(lnb + 8 * F.lane), y1 = d1 * rstd * *(const f32x4*)(lng + 8 * F.lane + 4) + *(const f32x4*)(lnb + 8 * F.lane + 4);
        f32x4 s0, s1;
#pragma unroll
        for (int e = 0; e < 4; ++e) { s0[e] = y0[e] * __builtin_amdgcn_rcpf(1.f + __expf(-y0[e])); s1[e] = y1[e] * __builtin_amdgcn_rcpf(1.f + __expf(-y1[e])); }
        v4u ov; ov.x = pk2(s0[0], s0[1]); ov.y = pk2(s0[2], s0[3]); ov.z = pk2(s1[0], s1[1]); ov.w = pk2(s1[2], s1[3]);
        *(v4u*)(CAT + (size_t)(row_base + tk) * 1024 + 8 * F.lane) = ov; }
}
__device__ __forceinline__ void phase_mix0(Frame& F, const Args& A, int only) {
    unsigned char* ws = A.ws;
    const bf16* P = (const bf16*)(ws + WS_PROJ); bf16* CAT = (bf16*)(ws + WS_CAT);
    if (only == 0 || only == 1) {   float w[31];
#pragma unroll
        for (int k = 0; k < 31; ++k) w[k] = A.in[10][k * 512 + F.tid];
        cf2_t we[15], wo[15];
#pragma unroll
        for (int q = 0; q < 15; ++q) { we[q].x = w[2 * q]; we[q].y = w[2 * q + 1]; wo[q].x = w[2 * q + 1]; wo[q].y = w[2 * q + 2]; }
        const float cb = A.in[11][F.tid];
        v4u pre[8]; const int ch0 = (F.vcu + 128) % F.G;
        __syncthreads();
        if (ch0 < 1152) conv_load(P, ch0, F.tid, pre);
        for (int ch = ch0; ch < 1152; ch += F.G) conv_chunk(F, P, we, wo, w[0], w[30], cb, A.in[12], A.in[13], CAT, ch, ch + F.G < 1152 ? ch + F.G : -1, pre);
        __syncthreads();
    }
    if (only == 0 || only == 2 || only == 4) { int bt_hp = -1; for (int u = F.vcu; u < 1024; u += F.G) att::na_pair_unit(F, P, A.in[14], CAT, u >> 6, u & 15, (u >> 4) & 3, only == 4, bt_hp); }
    if (only == 0 || only == 3) for (int u = F.vcu; u < 128; u += F.G) att::na_unit<false>(F, P, A.in[14], CAT, u >> 3, u & 3, (u >> 2) & 1);
}
__device__ __forceinline__ void phase_attn1(Frame& F, const Args& A, int abl) {
    unsigned char* ws = A.ws;
    const bf16* QKV = (const bf16*)(ws + WS_PROJ); bf16* CAT = (bf16*)(ws + WS_CAT);
    for (int u = F.vcu; u < 256; u += F.G) att::win_super(F, QKV, (const bf16*)(ws + WS_CTXKV) - (size_t)NL * 1536, A.in[18], CAT, u >> 4, (u >> 2) & 3, u & 3);
}

#ifndef REP_MASK
#define REP_MASK 0
#endif
#define REP(k) ((REP_MASK >> (k)) & 1)
#define PH(k, ...) if (IN(k)) { __VA_ARGS__ SEAM(k); }
#define MOE_LAYER(L_, P5, HINL, HINC) \
    PH(P5, phase_ln1<L_>(F, args, dry);) \
    PH(P5 + 2, moe_tiles<L_>(F);     \
        pg8::Gemm g{(const bf16*)(ws + WS_ACT), (const bf16*)(ws + WS_WGU) + (size_t)L_ * 16 * 512 * 1024, 0, 0, 1024}; \
        pg8::OrderMoE<2> S; S.init((const LAS int*)(F.lds + MOE_LDS), (const int*)(ws + WS_LIST), F.G, (int)blockIdx.x); S.n = (S.nwg / F.G) * F.G; \
        pg8::EpiGLU E{(bf16*)(ws + WS_CAT), (const float*)(ws + WS_LISTW), (const LAS int*)(F.lds + MOE_LDS), 0}; \
        pg8::gemm_phase<pg8::EpiGLU, pg8::OrderMoE<2>, true, true, true>(F.lds, g, S, E);) \
    PH(P5 + 3, moe_tiles<L_>(F); int kdn = 256; asm volatile("" : "+s"(kdn)); \
        unsigned* upf = (unsigned*)(F.ctl + CW_UPC) + L_ * 20480; \
        const int nup = ((const LAS int*)(F.lds + MOE_LDS))[16] * 2, nupa = (nup / F.G) * F.G, nleft = nup - nupa; \
        if (nleft > 0) {     \
            pg8::Gemm g{(const bf16*)(ws + WS_ACT), (const bf16*)(ws + WS_WGU) + (size_t)L_ * 16 * 512 * 1024, 0, 0, 1024}; \
            pg8::OrderMoE<2> S; S.init((const LAS int*)(F.lds + MOE_LDS), (const int*)(ws + WS_LIST), F.G, (int)blockIdx.x); \
            S.lo = nupa; S.n = nleft; S.remap = 0; S.sig = 1; S.flag = upf; S.lcnt = (LAS unsigned*)(F.lds + MOE_LDS) + 60; \
            pg8::EpiGLU E{(bf16*)(ws + WS_CAT), (const float*)(ws + WS_LISTW), (const LAS int*)(F.lds + MOE_LDS), 1}; \
            pg8::gemm_phase<pg8::EpiGLU, pg8::OrderMoE<2>, true, true, true>(F.lds, g, S, E); \
            __syncthreads(); } \
        {   pg8::Gemm g{(const bf16*)(ws + WS_CAT), (const bf16*)(ws + WS_WD) + (size_t)L_ * 16 * 1024 * 256, 0, 0, kdn}; \
            pg8::OrderMoE<4> S; S.init((const LAS int*)(F.lds + MOE_LDS), (const int*)(ws + WS_LIST), F.G, (int)blockIdx.x); \
            S.ns = (nleft + 7) & ~7; S.nr = nleft > 0 ? 3 : 0; S.rt_dep = nupa / 2; S.flag = upf; \
            pg8::EpiScatter E{(bf16*)(ws + WS_PROJ), (const int*)(ws + WS_LIST), (const LAS int*)(F.lds + MOE_LDS), NT, 0}; \
            pg8::gemm_phase<pg8::EpiScatter, pg8::OrderMoE<4>, true, true>(F.lds, g, S, E); }) \
    PH(P5 + 4, phase_ln2<L_>(F, args, dry); \
        if (L_ == 0) {     \
            __syncthreads(); \
            pg8::Gemm g{ACT, (const bf16*)(ws + WS_WIN1), NT, 1536, 1024}; pg8::OrderL1 S; S.init(F.G, (int)blockIdx.x, 1, (unsigned*)(F.ctl + CW_CTXF)); \
            pg8::EpiRope E{(bf16*)(ws + WS_CTXKV) - (size_t)NL * 1536, (const LAS float*)(F.lds + 131072)}; \
            pg8::gemm_phase<pg8::EpiRope, pg8::OrderL1, true, true>(F.lds, g, S, E); })

__global__ void __launch_bounds__(NTHR, 2) mk_fwd(Args args) {
    extern __shared__ __attribute__((aligned(16))) unsigned char lds[];
    Frame F;
    F.lds = (LAS unsigned char*)lds;
    F.MISC = (volatile LAS unsigned*)(F.lds + MISC_OFF);
    F.tid = threadIdx.x; F.lane = F.tid & 63; F.wave = __builtin_amdgcn_readfirstlane(F.tid >> 6);
    F.G = gridDim.x; { const int bx = blockIdx.x; F.vcu = (F.G % 8 == 0) ? (bx % 8) * (F.G / 8) + bx / 8 : bx; }
    unsigned char* ws = args.ws;
    F.ctl = (gu32*)(ws + WS_CTL);
    for (int u = F.tid; u < (LDS_BYTES - LDSCTL_OFF) / 4; u += NTHR) ((LAS unsigned*)(F.lds + LDSCTL_OFF))[u] = 0u;
    __syncthreads();
    XcdBarrier bar = xcd_barrier_post((unsigned*)(F.ctl + CW_BAR) + args.li * XCD_BAR_WORDS, F.MISC + 8);
    const int lo = args.ph_lo, hi = args.ph_hi;
#define IN(k) (lo <= (k) && (k) < hi)
#define SEAM(k) do { if (IN(k) && (k) + 1 < hi) xcd_barrier(bar); } while (0)
    float* MOD = (float*)(ws + WS_MOD);
    bf16* ACT = (bf16*)(ws + WS_ACT); bf16* PROJ = (bf16*)(ws + WS_PROJ); bf16* CAT = (bf16*)(ws + WS_CAT);
    constexpr bool dry = false;

    PH(0, phase_mods(F, args.in[1], args.in[3], args.in[4], args.in[5], MOD, (float*)(ws + WS_ROPEC), (float*)(ws + WS_ROPES));)
    PH(1, phase_prep(F, args);)
    PH(2,
        pg8::Gemm g{ACT, (const bf16*)(ws + WS_WIN0), NT, 2560, 1024}; pg8::StaticOrder S; S.init(NT, 2560, F.G, (int)blockIdx.x);
        pg8::EpiIn0 E{PROJ, (const float*)(ws + WS_BIN0P), att::C2, 0};
        pg8::gemm_phase<pg8::EpiIn0, pg8::StaticOrder, true, true>(F.lds, g, S, E);
        tail_items(F, args, (NT / 256) * 10, PI_EXP1, PI_ALL);)
    PH(3, phase_mix0(F, args, 0);)
    PH(4,
        pg8::Gemm g{CAT, (const bf16*)(ws + WS_WOUT0), NT, 1024, 1024}; pg8::StaticOrder S; S.init(NT, 1024, F.G, (int)blockIdx.x);
        pg8::EpiBias E{PROJ, 1024, args.in[16], 0, 0, 1.0f, 0};
        pg8::gemm_phase<pg8::EpiBias, pg8::StaticOrder, true, true>(F.lds, g, S, E);
        tail_items(F, args, (NT / 256) * 4, PI_L0W, PI_EXP1);)
    MOE_LAYER(0, 5, args.in[0], args.in[2])
    PH(10,
        pg8::Gemm g{ACT, (const bf16*)(ws + WS_WIN1), NT, 1536, 1024}; pg8::OrderL1 S; S.init(F.G, (int)blockIdx.x, 0, nullptr);
        LAS float* RT = (LAS float*)(F.lds + 131072);
        for (int idx = F.tid; idx < 1536; idx += NTHR) { const int p = idx >> 4, i = idx & 15, src = p < 32 ? p * 2048 + i : (p - 32) * 32 + 16 + i;
            RT[idx] = ((const float*)(ws + WS_ROPEC))[src]; RT[1536 + idx] = ((const float*)(ws + WS_ROPES))[src]; }
        __syncthreads();
        pg8::EpiRope E{PROJ, RT};
        pg8::gemm_phase<pg8::EpiRope, pg8::OrderL1, true, true>(F.lds, g, S, E);
        )
    PH(11, phase_attn1(F, args, 0);)
    PH(12,
        pg8::Gemm g{CAT, (const bf16*)(ws + WS_WOUT1), NL, 1024, 1024}; pg8::StaticOrder S; S.init(NL, 1024, F.G, (int)blockIdx.x);
        pg8::EpiBias E{PROJ, 1024, nullptr, 0, 0, 1.0f, 0};
        pg8::gemm_phase<pg8::EpiBias, pg8::StaticOrder, true, true>(F.lds, g, S, E);)
    MOE_LAYER(1, 13, HL, HC)
#undef IN
#undef SEAM
}

static int g_grid = 0;
static void launch_mk(const Args& base, int lo, int hi, int li, hipStream_t stream, int only = 0) {
    Args a = base; a.ph_lo = lo; a.ph_hi = hi; a.li = li; a.pad = (li > 0 ? 1 : 0) | (only << 1);
    hipLaunchKernelGGL(mk_fwd, dim3(g_grid), dim3(NTHR), LDS_BYTES, stream, a);
}
extern "C" void kernel_launch(void* const* d_in, const int* in_sizes, int n_in, void* d_out, int out_size, void* d_ws, size_t ws_size, hipStream_t stream) {
    if (ws_size < WS_END || n_in != 25) { fprintf(stderr, "kernel_launch: unexpected ws_size %zu / n_in %d\n", ws_size, n_in); return; }
    if (g_grid == 0) {
        int dev = 0, cus = 0;
        if (hipGetDevice(&dev) != hipSuccess || hipDeviceGetAttribute(&cus, hipDeviceAttributeMultiprocessorCount, dev) != hipSuccess) { g_grid = -1; return; }
        if (hipFuncSetAttribute((const void*)mk_fwd, hipFuncAttributeMaxDynamicSharedMemorySize, LDS_BYTES) != hipSuccess) { g_grid = -1; return; }
        g_grid = cus;
    }
    if (g_grid < 0) return;
    const float* x = (const float*)d_in[0]; const float* ctx = (const float*)d_in[2];
    const float* ln_g = (const float*)d_in[6]; const float* ln_b = (const float*)d_in[7];
    const float* conv_w = (const float*)d_in[10]; const float* conv_b = (const float*)d_in[11];
    const float* conv_ln_g = (const float*)d_in[12]; const float* conv_ln_b = (const float*)d_in[13]; const float* na_rpb = (const float*)d_in[14];
    const float* gqa_sink = (const float*)d_in[18]; const float* router_g = (const float*)d_in[20]; const float* router_e = (const float*)d_in[21];
    const float* wg = (const float*)d_in[22]; const float* wu = (const float*)d_in[23]; const float* wd = (const float*)d_in[24];
    unsigned char* ws = (unsigned char*)d_ws;
    float* MOD = (float*)(ws + WS_MOD); int* tok_e = (int*)(ws + WS_TOKE); float* tok_w = (float*)(ws + WS_TOKW);
    float* HC = (float*)(ws + WS_HC); float* HL = (float*)d_out;
    bf16* ACT = (bf16*)(ws + WS_ACT); bf16* PROJ = (bf16*)(ws + WS_PROJ); bf16* CAT = (bf16*)(ws + WS_CAT);
    (void)hipMemsetAsync(ws + WS_CTL, 0, CTL_ZERO_BYTES, stream);
    Args base{};
    for (int i = 0; i < 25; ++i) base.in[i] = (const float*)d_in[i];
    base.out = (float*)d_out; base.ws = ws;

    launch_mk(base, 0, 18, 0, stream);
}
```
